# Optimizing an MI355X kernel written in HIP

```python
import math
import jax
import jax.numpy as jnp
from jax import lax
import numpy as np

D_MODEL = 1024
BATCH = 1
SEQ = 16384
DEPTH = 2

GRID_W = 64
CTX_LEN = 256
HEAD_DIM = 64

NA_HEADS = 8
NA_WIDTH = NA_HEADS * HEAD_DIM
NA_KH = 8
NA_KW = 16
HY_WIDTH = D_MODEL - NA_WIDTH
HY_SHORT = 3
HY_BANDS = 16
HY_EMB = 1 + 2 * HY_BANDS
HY_FILT_HID = 64
HY_DECAY_PCT_MIN = 0.3
HY_DECAY_PCT_MAX = 1.5
HY_DECAY_TARGET = 1e-2
AB_IN = 3 * NA_WIDTH + 3 * HY_WIDTH

GQA_HEADS = 8
GQA_KV_HEADS = 2
GQA_WIDTH = GQA_HEADS * HEAD_DIM
GQA_KV_WIDTH = GQA_KV_HEADS * HEAD_DIM
Q_BLOCK = 128
ROPE_THETA = 10000.0
S5_WIDTH = D_MODEL - GQA_WIDTH
S5_GROUP = 16
S5_GROUPS = S5_WIDTH // S5_GROUP
S5_STATE = 64
CD_IN = GQA_WIDTH + 2 * GQA_KV_WIDTH + S5_WIDTH

N_EXPERTS = 256
TOP_K = 8
N_EXPERT_GROUPS = 8
TOPK_GROUPS = 4
EXPERT_FF = 256
ROUTED_SCALE = 2.5
EXPERT_BLOCK = 128

N_AB = (DEPTH + 1) // 2
N_CD = DEPTH // 2
DEEPNORM_ALPHA = (2.0 * DEPTH) ** 0.25
DEEPNORM_BETA = (8.0 * DEPTH) ** -0.25
LN_EPS = 1e-5
RMS_EPS = 1e-6

kernel_name = 'hybrid_na_hyena_s5_gqa_moe_dit'


def layer_norm(x, g, b):
    xf = x.astype(jnp.float32)
    mu = jnp.mean(xf, axis=-1, keepdims=True)
    var = jnp.mean(jnp.square(xf - mu), axis=-1, keepdims=True)
    return ((xf - mu) * lax.rsqrt(var + LN_EPS) * g + b).astype(x.dtype)


def rms_norm(x, g):
    xf = x.astype(jnp.float32)
    return (xf * lax.rsqrt(jnp.mean(xf * xf, axis=-1, keepdims=True) + RMS_EPS) * g).astype(x.dtype)


def split_heads(t, n_heads):
    return t.reshape(t.shape[:-1] + (n_heads, HEAD_DIM))


def modulation(cvec, w_mod, b_mod):
    return jnp.split(jax.nn.silu(cvec) @ w_mod + b_mod, 6, axis=-1)


def grid_positions(l):
    t = jnp.arange(l)
    return (t // GRID_W).astype(jnp.float32), (t % GRID_W).astype(jnp.float32)


def rope_2d(x, row, col):
    half = x.shape[-1] // 2
    inv_freq = ROPE_THETA ** (-jnp.arange(0, half, 2, dtype=jnp.float32) / half)

    def rotate(xp, pos):
        ang = pos[:, None] * inv_freq[None]
        cos = jnp.cos(ang)[None, :, None, :]
        sin = jnp.sin(ang)[None, :, None, :]
        x1 = xp[..., 0::2].astype(jnp.float32)
        x2 = xp[..., 1::2].astype(jnp.float32)
        return jnp.stack([x1 * cos - x2 * sin, x1 * sin + x2 * cos], axis=-1).reshape(xp.shape).astype(x.dtype)

    return jnp.concatenate([rotate(x[..., :half], row), rotate(x[..., half:], col)], axis=-1)


def context_attention(q, k, v):
    b, nq, hq, dh = q.shape
    hkv = k.shape[2]
    qg = q.reshape(b, nq, hkv, hq // hkv, dh) * dh ** -0.5
    s = jnp.einsum('bqgrd,bkgd->bgrqk', qg, k)
    p = jax.nn.softmax(s.astype(jnp.float32), axis=-1).astype(v.dtype)
    return jnp.einsum('bgrqk,bkgd->bqgrd', p, v).reshape(b, nq, hq * dh)


def neighbourhood_attention(q, k, v, k_ctx, v_ctx, rpb):
    b, l, h, dh = q.shape
    rows = l // GRID_W
    kh = min(NA_KH, rows)
    kw = NA_KW
    qg = q.reshape(b, rows, GRID_W, h, dh) * dh ** -0.5
    kg = k.reshape(b, rows, GRID_W, h, dh)
    vg = v.reshape(b, rows, GRID_W, h, dh)
    cols = jnp.arange(GRID_W)
    col_idx = jnp.clip(cols - kw // 2, 0, GRID_W - kw)[:, None] + jnp.arange(kw)[None]
    col_bias = rpb[:, :, col_idx - cols[:, None] + NA_KW - 1]
    n_win = kh * kw

    def query_row(args):
        r, q_r = args
        rs = jnp.clip(r - kh // 2, 0, rows - kh)
        k_rows = lax.dynamic_slice_in_dim(kg, rs, kh, axis=1)
        v_rows = lax.dynamic_slice_in_dim(vg, rs, kh, axis=1)
        k_win = k_rows[:, :, col_idx]
        v_win = v_rows[:, :, col_idx]
        bias = col_bias[:, rs + jnp.arange(kh) - r + NA_KH - 1]
        s_win = jnp.einsum('bchd,bicjhd->bhcij', q_r, k_win) + jnp.transpose(bias, (0, 2, 1, 3))[None]
        s_ctx = jnp.einsum('bchd,bnhd->bhcn', q_r, k_ctx)
        s = jnp.concatenate([s_win.reshape(b, h, GRID_W, n_win), s_ctx.astype(s_win.dtype)], axis=-1)
        p = jax.nn.softmax(s.astype(jnp.float32), axis=-1).astype(v.dtype)
        p_win = p[..., :n_win].reshape(b, h, GRID_W, kh, kw)
        return (jnp.einsum('bhcij,bicjhd->bchd', p_win, v_win)
                + jnp.einsum('bhcn,bnhd->bchd', p[..., n_win:], v_ctx))

    out = lax.map(query_row, (jnp.arange(rows), jnp.moveaxis(qg, 1, 0)))
    return jnp.moveaxis(out, 0, 1).reshape(b, l, h * dh)


def short_conv(u, w, bias):
    l = u.shape[1]
    pad = HY_SHORT // 2
    up = jnp.pad(u, ((0, 0), (pad, HY_SHORT - 1 - pad), (0, 0)))
    return sum(up[:, j:j + l] * w[j] for j in range(HY_SHORT)) + bias


def implicit_filter(l, f_w1, f_b1, f_freq, f_w2, f_b2, f_w3):
    pos = jnp.arange(l, dtype=jnp.float32)
    t = pos / max(l - 1, 1)
    bands = jnp.linspace(1e-4, HY_BANDS - 1, HY_BANDS, dtype=jnp.float32)
    ang = (2.0 * math.pi / l) * pos[:, None] * bands[None]
    z = jnp.concatenate([t[:, None], jnp.cos(ang), -jnp.sin(ang)], axis=-1)
    hid = jnp.sin(f_freq * (z @ f_w1 + f_b1))
    hid = jnp.sin(f_freq * (hid @ f_w2 + f_b2))
    taps = (hid @ f_w3).astype(jnp.float32)
    deltas = jnp.abs(jnp.linspace(math.log(HY_DECAY_TARGET) / HY_DECAY_PCT_MAX,
                                  math.log(HY_DECAY_TARGET) / HY_DECAY_PCT_MIN, HY_WIDTH, dtype=jnp.float32))
    window = jnp.exp(-t[:, None] * deltas[None])
    fwd = taps[:, :HY_WIDTH] * window
    bwd = taps[:, HY_WIDTH:] * window
    filt2 = jnp.concatenate([fwd, jnp.zeros((1, HY_WIDTH), jnp.float32), bwd[:0:-1]], axis=0)
    return filt2 / jnp.sum(jnp.abs(filt2), axis=0, keepdims=True)


def long_conv(u, filt2):
    l = u.shape[1]
    u_f = jnp.fft.rfft(u.astype(jnp.float32), n=2 * l, axis=1)
    f_f = jnp.fft.rfft(filt2, n=2 * l, axis=0)
    return jnp.fft.irfft(u_f * f_f[None], n=2 * l, axis=1)[:, :l].astype(u.dtype)


def hyena(u, conv_w, conv_b, f_w1, f_b1, f_freq, f_w2, f_b2, f_w3, skip):
    l = u.shape[1]
    x0, x1, v = jnp.split(short_conv(u, conv_w, conv_b), 3, axis=-1)
    z = x1 * v
    z = long_conv(z, implicit_filter(l, f_w1, f_b1, f_freq, f_w2, f_b2, f_w3)) + z * skip
    return x0 * z


def _ssm_combine(left, right):
    a_l, b_l = left
    a_r, b_r = right
    return a_r * a_l, a_r * b_l + b_r


def s5_scan(u, a_bar, b_bar, reverse, s0):
    bu = jnp.einsum('gpk,blgk->blgp', b_bar, u.astype(jnp.complex64))
    if s0 is not None:
        bu = bu.at[:, -1 if reverse else 0].add(a_bar * s0)
    a = jnp.broadcast_to(a_bar, bu.shape)
    _, s = lax.associative_scan(_ssm_combine, (a, bu), axis=1, reverse=reverse)
    return s


def s5_bidirectional(u_ctx, u_lat, a_re, a_im, log_dt, b_re, b_im, c_re, c_im, d_skip, glu_w, glu_b, need_ctx):
    lam = lax.complex(a_re.astype(jnp.float32), a_im.astype(jnp.float32))
    dt = jnp.exp(log_dt.astype(jnp.float32))[..., None]
    a_bar = jnp.exp(lam * dt)
    b_bar = ((a_bar - 1.0) / lam)[..., None] * lax.complex(b_re.astype(jnp.float32), b_im.astype(jnp.float32))
    c_mat = lax.complex(c_re.astype(jnp.float32), c_im.astype(jnp.float32))

    def groups(u):
        return u.reshape(u.shape[:2] + (S5_GROUPS, S5_GROUP)).astype(jnp.float32)

    def readout(u, s_fwd, s_bwd):
        y = (jnp.real(jnp.einsum('gkp,blgp->blgk', c_mat[0], s_fwd))
             + jnp.real(jnp.einsum('gkp,blgp->blgk', c_mat[1], s_bwd)))
        y = jax.nn.gelu(y.reshape(u.shape) + d_skip * u)
        return (y * jax.nn.sigmoid(y @ glu_w + glu_b)).astype(u.dtype)

    gc = groups(u_ctx)
    ctx_f = s5_scan(gc, a_bar[0], b_bar[0], False, None)
    ctx_b = s5_scan(gc, a_bar[1], b_bar[1], True, None)
    gl = groups(u_lat)
    lat_f = s5_scan(gl, a_bar[0], b_bar[0], False, ctx_f[:, -1])
    lat_b = s5_scan(gl, a_bar[1], b_bar[1], True, ctx_b[:, 0])
    y_lat = readout(u_lat, lat_f, lat_b)
    y_ctx = readout(u_ctx, ctx_f, ctx_b) if need_ctx else None
    return y_ctx, y_lat


def blocked_gqa(q, k, v, k_ctx, v_ctx):
    b, l, hq, dh = q.shape
    hkv = k.shape[2]
    k_all = jnp.concatenate([k, k_ctx], axis=1)
    v_all = jnp.concatenate([v, v_ctx], axis=1)
    qb = (q * dh ** -0.5).reshape(b, l // Q_BLOCK, Q_BLOCK, hkv, hq // hkv, dh)

    def query_block(q_i):
        s = jnp.einsum('bqgrd,bkgd->bgrqk', q_i, k_all)
        p = jax.nn.softmax(s.astype(jnp.float32), axis=-1).astype(v_all.dtype)
        return jnp.einsum('bgrqk,bkgd->bqgrd', p, v_all)

    out = lax.map(query_block, jnp.moveaxis(qb, 1, 0))
    return jnp.moveaxis(out, 0, 1).reshape(b, l, hq * dh)


def mixer_ab(h_ctx, h_lat, w_in, w_out, rpb, conv_w, conv_b, f_w1, f_b1, f_freq, f_w2, f_b2, f_w3, skip, need_ctx):
    filt = (conv_w, conv_b, f_w1, f_b1, f_freq, f_w2, f_b2, f_w3, skip)
    q_l, k_l, v_l, u_l = jnp.split(h_lat @ w_in, [NA_WIDTH, 2 * NA_WIDTH, 3 * NA_WIDTH], axis=-1)
    k_c, v_c = jnp.split(h_ctx @ w_in[:, NA_WIDTH:3 * NA_WIDTH], 2, axis=-1)
    k_c, v_c = split_heads(k_c, NA_HEADS), split_heads(v_c, NA_HEADS)
    a_lat = neighbourhood_attention(split_heads(q_l, NA_HEADS), split_heads(k_l, NA_HEADS),
                                    split_heads(v_l, NA_HEADS), k_c, v_c, rpb)
    y_lat = jnp.concatenate([a_lat, hyena(u_l, *filt)], axis=-1) @ w_out
    y_ctx = None
    if need_ctx:
        a_ctx = context_attention(split_heads(h_ctx @ w_in[:, :NA_WIDTH], NA_HEADS), k_c, v_c)
        y_ctx = jnp.concatenate([a_ctx, hyena(h_ctx @ w_in[:, 3 * NA_WIDTH:], *filt)], axis=-1) @ w_out
    return y_ctx, y_lat


def mixer_cd(h_ctx, h_lat, w_in, w_out, q_gain, k_gain, a_re, a_im, log_dt, b_re, b_im, c_re, c_im,
             d_skip, glu_w, glu_b, need_ctx):
    l = h_lat.shape[1]
    cuts = [GQA_WIDTH, GQA_WIDTH + GQA_KV_WIDTH, GQA_WIDTH + 2 * GQA_KV_WIDTH]
    q_l, k_l, v_l, u_l = jnp.split(h_lat @ w_in, cuts, axis=-1)
    k_c, v_c, u_c = jnp.split(h_ctx @ w_in[:, GQA_WIDTH:], [GQA_KV_WIDTH, 2 * GQA_KV_WIDTH], axis=-1)
    k_c = rms_norm(split_heads(k_c, GQA_KV_HEADS), k_gain)
    v_c = split_heads(v_c, GQA_KV_HEADS)
    row, col = grid_positions(l)
    q_l = rope_2d(rms_norm(split_heads(q_l, GQA_HEADS), q_gain), row, col)
    k_l = rope_2d(rms_norm(split_heads(k_l, GQA_KV_HEADS), k_gain), row, col)
    att_lat = blocked_gqa(q_l, k_l, split_heads(v_l, GQA_KV_HEADS), k_c, v_c)
    ssm_ctx, ssm_lat = s5_bidirectional(u_c, u_l, a_re, a_im, log_dt, b_re, b_im, c_re, c_im,
                                        d_skip, glu_w, glu_b, need_ctx)
    y_lat = jnp.concatenate([att_lat, ssm_lat], axis=-1) @ w_out
    y_ctx = None
    if need_ctx:
        q_c = rms_norm(split_heads(h_ctx @ w_in[:, :GQA_WIDTH], GQA_HEADS), q_gain)
        y_ctx = jnp.concatenate([context_attention(q_c, k_c, v_c), ssm_ctx], axis=-1) @ w_out
    return y_ctx, y_lat


def swiglu(x, w_gate, w_up, w_down):
    return (jax.nn.silu(x @ w_gate) * (x @ w_up)) @ w_down


def moe_ffn(h, router_w, router_bias, exp_w_gate, exp_w_up, exp_w_down, sh_w_gate, sh_w_up, sh_w_down):
    n, d = h.shape
    scores = jax.nn.sigmoid((h @ router_w).astype(jnp.float32))
    grouped = (scores + router_bias.astype(jnp.float32)).reshape(n, N_EXPERT_GROUPS, -1)
    group_score = jnp.sum(lax.top_k(grouped, 2)[0], axis=-1)
    _, top_groups = lax.top_k(group_score, TOPK_GROUPS)
    keep = jnp.sum(jax.nn.one_hot(top_groups, N_EXPERT_GROUPS, dtype=jnp.float32), axis=1) > 0
    masked = jnp.where(keep[..., None], grouped, -jnp.inf).reshape(n, N_EXPERTS)
    _, top_e = lax.top_k(masked, TOP_K)
    gate = jnp.take_along_axis(scores, top_e, axis=1)
    gate = ROUTED_SCALE * gate / jnp.sum(gate, axis=-1, keepdims=True)

    flat_e = top_e.reshape(-1)
    order = jnp.argsort(flat_e)
    sorted_e = flat_e[order]
    counts = jnp.bincount(flat_e, length=N_EXPERTS)
    padded = (counts + EXPERT_BLOCK - 1) // EXPERT_BLOCK * EXPERT_BLOCK
    pad_end = jnp.cumsum(padded)
    start = jnp.cumsum(counts) - counts
    dest = (pad_end - padded)[sorted_e] + jnp.arange(n * TOP_K) - start[sorted_e]
    n_blocks = -(-(n * TOP_K + N_EXPERTS * (EXPERT_BLOCK - 1)) // EXPERT_BLOCK)
    n_slots = n_blocks * EXPERT_BLOCK
    slot_tok = jnp.full((n_slots,), n, jnp.int32).at[dest].set((order // TOP_K).astype(jnp.int32))
    slot_gate = jnp.zeros((n_slots,), h.dtype).at[dest].set(gate.reshape(-1)[order].astype(h.dtype))
    block_e = jnp.minimum(jnp.searchsorted(pad_end, jnp.arange(n_blocks) * EXPERT_BLOCK, side='right'),
                          N_EXPERTS - 1)
    h_pad = jnp.concatenate([h, jnp.zeros((1, d), h.dtype)], axis=0)

    def expert_block(args):
        tok, e = args
        return swiglu(h_pad[tok], exp_w_gate[e], exp_w_up[e], exp_w_down[e])

    ys = lax.map(expert_block, (slot_tok.reshape(n_blocks, EXPERT_BLOCK), block_e))
    routed = jnp.zeros((n + 1, d), h.dtype).at[slot_tok].add(ys.reshape(-1, d) * slot_gate[:, None])[:n]
    return routed + swiglu(h, sh_w_gate, sh_w_up, sh_w_down)


def setup_inputs(seed: int = 0) -> dict:
    key = jax.random.key(seed)
    ks = iter(jax.random.split(key, 48))

    def nrm(shape, scale):
        return scale * jax.random.normal(next(ks), shape, jnp.float32)

    d = D_MODEL
    beta = DEEPNORM_BETA
    return {
        'x': nrm((BATCH, SEQ, d), 1.0),
        'c': nrm((BATCH, d), 1.0),
        'ctx': nrm((BATCH, CTX_LEN, d), 1.0),
        'c_ctx': nrm((d,), 1.0),
        'w_mod': nrm((DEPTH, d, 6 * d), 0.5 * d ** -0.5),
        'b_mod': nrm((DEPTH, 6 * d), 0.1),
        'ln_mix_g': 1.0 + nrm((DEPTH, d), 0.05),
        'ln_mix_b': nrm((DEPTH, d), 0.05),
        'ln_ffn_g': 1.0 + nrm((DEPTH, d), 0.05),
        'ln_ffn_b': nrm((DEPTH, d), 0.05),
        'ab_w_in': nrm((N_AB, d, AB_IN), d ** -0.5),
        'ab_w_out': nrm((N_AB, NA_WIDTH + HY_WIDTH, d), beta * (NA_WIDTH + HY_WIDTH) ** -0.5),
        'na_rpb': nrm((N_AB, NA_HEADS, 2 * NA_KH - 1, 2 * NA_KW - 1), 0.5),
        'hy_conv_w': nrm((N_AB, HY_SHORT, 3 * HY_WIDTH), 0.6),
        'hy_conv_b': nrm((N_AB, 3 * HY_WIDTH), 0.1),
        'hy_f_w1': nrm((N_AB, HY_EMB, HY_FILT_HID), 2.0 * HY_EMB ** -0.5),
        'hy_f_b1': nrm((N_AB, HY_FILT_HID), 0.5),
        'hy_f_freq': 1.0 + nrm((N_AB, HY_FILT_HID), 0.1),
        'hy_f_w2': nrm((N_AB, HY_FILT_HID, HY_FILT_HID), HY_FILT_HID ** -0.5),
        'hy_f_b2': nrm((N_AB, HY_FILT_HID), 0.5),
        'hy_f_w3': nrm((N_AB, HY_FILT_HID, 2 * HY_WIDTH), HY_FILT_HID ** -0.5),
        'hy_skip': nrm((N_AB, HY_WIDTH), 0.5),
        'cd_w_in': nrm((N_CD, d, CD_IN), d ** -0.5),
        'cd_w_out': nrm((N_CD, GQA_WIDTH + S5_WIDTH, d), beta * (GQA_WIDTH + S5_WIDTH) ** -0.5),
        'q_norm_g': 1.0 + nrm((N_CD, HEAD_DIM), 0.05),
        'k_norm_g': 1.0 + nrm((N_CD, HEAD_DIM), 0.05),
        's5_a_re': -0.5 + nrm((N_CD, 2, S5_GROUPS, S5_STATE), 0.01),
        's5_a_im': jnp.pi * jnp.arange(S5_STATE, dtype=jnp.float32) + nrm((N_CD, 2, S5_GROUPS, S5_STATE), 0.01),
        's5_log_dt': jax.random.uniform(next(ks), (N_CD, 2, S5_GROUPS), jnp.float32,
                                        math.log(1e-3), math.log(1e-1)),
        's5_b_re': nrm((N_CD, 2, S5_GROUPS, S5_STATE, S5_GROUP), (2.0 * S5_GROUP) ** -0.5),
        's5_b_im': nrm((N_CD, 2, S5_GROUPS, S5_STATE, S5_GROUP), (2.0 * S5_GROUP) ** -0.5),
        's5_c_re': nrm((N_CD, 2, S5_GROUPS, S5_GROUP, S5_STATE), S5_STATE ** -0.5),
        's5_c_im': nrm((N_CD, 2, S5_GROUPS, S5_GROUP, S5_STATE), S5_STATE ** -0.5),
        's5_d': nrm((N_CD, S5_WIDTH), 1.0),
        's5_glu_w': nrm((N_CD, S5_WIDTH, S5_WIDTH), S5_WIDTH ** -0.5),
        's5_glu_b': nrm((N_CD, S5_WIDTH), 0.1),
        'router_w': nrm((DEPTH, d, N_EXPERTS), d ** -0.5),
        'router_bias': nrm((DEPTH, N_EXPERTS), 0.01),
        'exp_w_gate': nrm((DEPTH, N_EXPERTS, d, EXPERT_FF), d ** -0.5),
        'exp_w_up': nrm((DEPTH, N_EXPERTS, d, EXPERT_FF), d ** -0.5),
        'exp_w_down': nrm((DEPTH, N_EXPERTS, EXPERT_FF, d), beta * EXPERT_FF ** -0.5),
        'sh_w_gate': nrm((DEPTH, d, EXPERT_FF), d ** -0.5),
        'sh_w_up': nrm((DEPTH, d, EXPERT_FF), d ** -0.5),
        'sh_w_down': nrm((DEPTH, EXPERT_FF, d), beta * EXPERT_FF ** -0.5),
    }


def reference(x, c, ctx, c_ctx, w_mod, b_mod, ln_mix_g, ln_mix_b, ln_ffn_g, ln_ffn_b,
              ab_w_in, ab_w_out, na_rpb, hy_conv_w, hy_conv_b, hy_f_w1, hy_f_b1, hy_f_freq, hy_f_w2, hy_f_b2,
              hy_f_w3, hy_skip, cd_w_in, cd_w_out, q_norm_g, k_norm_g, s5_a_re, s5_a_im, s5_log_dt,
              s5_b_re, s5_b_im, s5_c_re, s5_c_im, s5_d, s5_glu_w, s5_glu_b,
              router_w, router_bias, exp_w_gate, exp_w_up, exp_w_down, sh_w_gate, sh_w_up, sh_w_down):
    b, l, d = x.shape
    n_ctx = ctx.shape[1]
    for i in range(DEPTH):
        need_ctx = i < DEPTH - 1
        sh1, sc1, g1, sh2, sc2, g2 = [m[:, None] for m in modulation(c, w_mod[i], b_mod[i])]
        csh1, csc1, cg1, csh2, csc2, cg2 = modulation(c_ctx, w_mod[i], b_mod[i])
        h_lat = x * (1 + sc1) + sh1
        h_ctx = ctx * (1 + csc1) + csh1
        j = i // 2
        if i % 2 == 0:
            y_ctx, y_lat = mixer_ab(h_ctx, h_lat, ab_w_in[j], ab_w_out[j], na_rpb[j], hy_conv_w[j], hy_conv_b[j],
                                    hy_f_w1[j], hy_f_b1[j], hy_f_freq[j], hy_f_w2[j], hy_f_b2[j], hy_f_w3[j],
                                    hy_skip[j], need_ctx)
        else:
            y_ctx, y_lat = mixer_cd(h_ctx, h_lat, cd_w_in[j], cd_w_out[j], q_norm_g[j], k_norm_g[j],
                                    s5_a_re[j], s5_a_im[j], s5_log_dt[j], s5_b_re[j], s5_b_im[j],
                                    s5_c_re[j], s5_c_im[j], s5_d[j], s5_glu_w[j], s5_glu_b[j], need_ctx)
        x = layer_norm(DEEPNORM_ALPHA * x + g1 * y_lat, ln_mix_g[i], ln_mix_b[i])
        moe_w = (router_w[i], router_bias[i], exp_w_gate[i], exp_w_up[i], exp_w_down[i],
                 sh_w_gate[i], sh_w_up[i], sh_w_down[i])
        hf_lat = x * (1 + sc2) + sh2
        if need_ctx:
            ctx = layer_norm(DEEPNORM_ALPHA * ctx + cg1 * y_ctx, ln_mix_g[i], ln_mix_b[i])
            hf_ctx = ctx * (1 + csc2) + csh2
            toks = jnp.concatenate([hf_ctx, hf_lat], axis=1).reshape(-1, d)
            y = moe_ffn(toks, *moe_w).reshape(b, n_ctx + l, d)
            ctx = layer_norm(DEEPNORM_ALPHA * ctx + cg2 * y[:, :n_ctx], ln_ffn_g[i], ln_ffn_b[i])
            y_lat = y[:, n_ctx:]
        else:
            y_lat = moe_ffn(hf_lat.reshape(-1, d), *moe_w).reshape(b, l, d)
        x = layer_norm(DEEPNORM_ALPHA * x + g2 * y_lat, ln_ffn_g[i], ln_ffn_b[i])
    return x
```

```cpp
#include <hip/hip_runtime.h>
#include <stdint.h>
#include <stdio.h>

#ifndef MK_SINGLE
#define MK_SINGLE 1
#endif

#define DM 1024
#define LSEQ 16384
#define NCTX 256
#define NT 16640
#define NEXP 256
#define NE1 257
#define ALPHA 1.41421356237f
#define NPH 20
#ifndef PROBE_DUP
#define PROBE_DUP -1
#endif
#define NTHR 512

typedef unsigned short bfr;
typedef __attribute__((ext_vector_type(8))) short bf16x8;
typedef __attribute__((ext_vector_type(16))) float f32x16;
typedef __attribute__((ext_vector_type(4))) float f32x4;
typedef __attribute__((ext_vector_type(4))) unsigned u32x4;
typedef __attribute__((ext_vector_type(2))) unsigned u32x2;

constexpr size_t al256(size_t x) { return (x + 255) & ~size_t(255); }
constexpr size_t CTL_BYTES = 65536;
constexpr size_t CTL_COUNT = 24576;
#define NREP 8
#define CSTRIDE 264
#define LCAP 2080
constexpr size_t CTL_NORM  = 20480;
constexpr size_t CTL_NORMC = 22528;
constexpr size_t WS_MOD    = CTL_BYTES;
constexpr size_t WS_WINT0  = al256(WS_MOD + 2 * 2 * 6144 * 4);
constexpr size_t WS_WOUTT0 = al256(WS_WINT0 + (size_t)3072 * 1024 * 2);
constexpr size_t WS_WINT1  = al256(WS_WOUTT0 + (size_t)1024 * 1024 * 2);
constexpr size_t WS_WOUTT1 = al256(WS_WINT1 + (size_t)1280 * 1024 * 2);
constexpr size_t WS_ROUT   = al256(WS_WOUTT1 + (size_t)1024 * 1024 * 2);
constexpr size_t WS_GLUT   = al256(WS_ROUT + (size_t)2 * 256 * 1024 * 2);
constexpr size_t WS_HF     = al256(WS_GLUT + (size_t)512 * 512 * 2);
constexpr size_t WS_HFC    = al256(WS_HF + (size_t)512 * 32768 * 4);
constexpr size_t WS_ABAR   = al256(WS_HFC + (size_t)512 * 512 * 4);
constexpr size_t WS_A64    = al256(WS_ABAR + 4096 * 8);
constexpr size_t WS_BBAR   = al256(WS_A64 + 4096 * 8);
constexpr size_t WS_CMAT   = al256(WS_BBAR + (size_t)4096 * 16 * 8);
constexpr size_t WS_H      = al256(WS_CMAT + (size_t)64 * 16 * 128 * 2);
constexpr size_t WS_QKVU   = al256(WS_H + (size_t)NT * 1024 * 2);
constexpr size_t WS_Z      = al256(WS_QKVU + (size_t)NT * 3072 * 2);
constexpr size_t WS_ATT    = al256(WS_Z + (size_t)512 * NT * 4);
constexpr size_t WS_PRE    = al256(WS_ATT + (size_t)NT * 1024 * 2);
constexpr size_t WS_X1     = al256(WS_PRE + (size_t)NT * 1024 * 4);
constexpr size_t WS_HFF    = al256(WS_X1 + (size_t)NT * 1024 * 4);
constexpr size_t WS_X2     = al256(WS_HFF + (size_t)NT * 1024 * 2);
constexpr size_t WS_LIST   = al256(WS_X2 + (size_t)NT * 1024 * 4);
constexpr size_t WS_GATE   = al256(WS_LIST + (size_t)256 * NT * 4);
constexpr size_t H1ROWS    = (size_t)NT * 9 + 257 * 128;
constexpr size_t WS_H1     = al256(WS_GATE + (size_t)NT * 9 * 4);
constexpr size_t WS_YS     = al256(WS_H1 + H1ROWS * 256 * 2);
constexpr size_t WS_QN     = al256(WS_YS + (size_t)NT * 9 * 1024 * 2);
constexpr size_t WS_KN     = al256(WS_QN + (size_t)LSEQ * 512 * 2);
constexpr size_t WS_SE     = al256(WS_KN + (size_t)NT * 128 * 2);
constexpr size_t WS_CIN    = al256(WS_SE + (size_t)260 * 4096 * 8);
constexpr size_t WS_Y5     = al256(WS_CIN + (size_t)260 * 4096 * 8);
constexpr size_t WS_VT     = al256(WS_Y5 + (size_t)LSEQ * 512 * 2);
constexpr size_t WS_VT0    = al256(WS_VT + (size_t)128 * NT * 2);
constexpr size_t WS_X0     = al256(WS_VT0 + (size_t)512 * NT * 2);
constexpr size_t WS_K0F    = al256(WS_X0 + (size_t)512 * NT * 4);
constexpr size_t WS_NORMP  = al256(WS_K0F + (size_t)512 * NT * 2);
constexpr size_t WS_END    = al256(WS_NORMP + (size_t)520 * 512 * 4);

constexpr int LDS_BYTES = 147456;

struct Params {
    const float* in[44];
    float* out;
    unsigned char* ws;
    int lo, hi;
};

#define XB_TMO      128
#define XB_XCNT(j)  (256  + 64 * (j))
#define XB_XSUB(j)  (1280 + 64 * (j))
#define XB_XGEN(j)  (2304 + 64 * (j))
#define XB_TOP      3328
#define XB_TOPGEN   3392
#define XCD_BAR_WORDS 3456
#define XB_SPIN_CAP (1u << 21)
#define LAS __attribute__((address_space(3)))

__device__ __forceinline__ unsigned xb_ld(unsigned* p)              { return __hip_atomic_load(p, __ATOMIC_RELAXED, __HIP_MEMORY_SCOPE_AGENT); }
__device__ __forceinline__ unsigned xb_add(unsigned* p, unsigned v) { return __hip_atomic_fetch_add(p, v, __ATOMIC_RELAXED, __HIP_MEMORY_SCOPE_AGENT); }
__device__ __forceinline__ unsigned xb_xcc_id() { return (unsigned)__builtin_amdgcn_s_getreg((3 << 11) | 20) & 0xFu; }
#define XB_SPIN(cond, bar) do { unsigned _sp = 0; while (cond) { __builtin_amdgcn_s_sleep(1); \
    if ((++_sp & 255u) == 0u) { if (xb_ld(&(bar)[XB_TMO])) break; if (_sp > XB_SPIN_CAP) { atomicAdd(&(bar)[XB_TMO], 1u); break; } } } } while (0)

struct XcdBarrier { unsigned* bar; unsigned x; volatile LAS unsigned* st; };

__device__ __forceinline__ XcdBarrier xcd_barrier_post(unsigned* bar, volatile LAS unsigned* st) {
    XcdBarrier b; b.bar = bar; b.x = xb_xcc_id(); b.st = st;
    if (threadIdx.x == 0) (void)xb_add(&bar[XB_XCNT(b.x)], 1u);
    return b;
}
__device__ __forceinline__ void xcd_barrier_complete(unsigned* bar, unsigned x, unsigned& nloc, unsigned& nx) {
    const unsigned G = gridDim.x * gridDim.y * gridDim.z;
    unsigned sum, cnt, mine, sp = 0u;
    for (;;) {
        sum = 0u; cnt = 0u; mine = 0u;
#pragma unroll
        for (unsigned j = 0; j < 16; ++j) { const unsigned c = xb_ld(&bar[XB_XCNT(j)]); sum += c; cnt += (c > 0u) ? 1u : 0u; mine = (j == x) ? c : mine; }
        if (sum == G) break;
        __builtin_amdgcn_s_sleep(1);
        if ((++sp & 255u) == 0u) { if (xb_ld(&bar[XB_TMO])) break; if (sp > XB_SPIN_CAP) { atomicAdd(&bar[XB_TMO], 1u); break; } }
    }
    nloc = mine > 0u ? mine : 1u; nx = cnt > 0u ? cnt : 1u;
}
__device__ __forceinline__ void xcd_barrier(const XcdBarrier& b) {
    asm volatile("s_waitcnt vmcnt(0)" ::: "memory");
    __syncthreads();
    if (threadIdx.x == 0) {
        unsigned* bar = b.bar;
        __builtin_amdgcn_s_waitcnt(0);
        unsigned nloc = b.st[0], nx = b.st[1];
        if (nloc == 0u) { xcd_barrier_complete(bar, b.x, nloc, nx); b.st[0] = nloc; b.st[1] = nx; }
        const unsigned old = xb_add(&bar[XB_XSUB(b.x)], 1u);
        const unsigned gen = old / nloc;
        if (old + 1u == (gen + 1u) * nloc) {
            __builtin_amdgcn_fence(__ATOMIC_RELEASE, "agent");
            asm volatile("s_waitcnt vmcnt(0)" ::: "memory");
            const unsigned og = xb_add(&bar[XB_TOP], 1u);
            const unsigned tg = og / nx;
            if (og + 1u == (tg + 1u) * nx) xb_add(&bar[XB_TOPGEN], 1u);
            else XB_SPIN(xb_ld(&bar[XB_TOPGEN]) == tg, bar);
            __builtin_amdgcn_fence(__ATOMIC_ACQUIRE, "agent");
            xb_add(&bar[XB_XGEN(b.x)], 1u);
            asm volatile("s_waitcnt vmcnt(0)" ::: "memory");
        } else {
            XB_SPIN(xb_ld(&bar[XB_XGEN(b.x)]) == gen, bar);
            __builtin_amdgcn_fence(__ATOMIC_ACQUIRE, "agent");
            asm volatile("s_waitcnt vmcnt(0)" ::: "memory");
        }
    }
    __syncthreads();
}

typedef __bf16 hbf16x2_t __attribute__((ext_vector_type(2)));
typedef float hf32x2_t __attribute__((ext_vector_type(2)));
__device__ __forceinline__ unsigned pack2(float a, float b) {
    hf32x2_t f = {a, b};
    return __builtin_bit_cast(unsigned, __builtin_convertvector(f, hbf16x2_t));
}
__device__ __forceinline__ bfr f2bf(float f) { return (bfr)(pack2(f, 0.f) & 0xffffu); }
__device__ __forceinline__ float bf2f(bfr h) { return __uint_as_float(((unsigned)h) << 16); }
__device__ __forceinline__ float bflo(unsigned u) { return __uint_as_float(u << 16); }
__device__ __forceinline__ float bfhi(unsigned u) { return __uint_as_float(u & 0xffff0000u); }
__device__ __forceinline__ float sigmoidf_(float x) { return 1.f / (1.f + __expf(-x)); }
__device__ __forceinline__ float siluf_(float x) { return x / (1.f + __expf(-x)); }
__device__ __forceinline__ float gelu_tanh(float x) {
    const float u = 0.7978845608028654f * (x + 0.044715f * x * x * x);
    return 0.5f * x * (1.f + tanhf(u));
}
__device__ __forceinline__ float wave_sum(float v) {
#define DPPADD(ctrl, rmask) v += __int_as_float(__builtin_amdgcn_update_dpp(0, __float_as_int(v), ctrl, rmask, 0xf, true))
    DPPADD(0x111, 0xf); DPPADD(0x112, 0xf); DPPADD(0x114, 0xf); DPPADD(0x118, 0xf);
    DPPADD(0x142, 0xa); DPPADD(0x143, 0xc);
#undef DPPADD
    return __int_as_float(__builtin_amdgcn_readlane(__float_as_int(v), 63));
}
__device__ __forceinline__ float wave_max_dpp(float v) {
#define DPPMAX(ctrl, rmask) v = fmaxf(v, __int_as_float(__builtin_amdgcn_update_dpp(__float_as_int(v), __float_as_int(v), ctrl, rmask, 0xf, false)))
    DPPMAX(0x111, 0xf); DPPMAX(0x112, 0xf); DPPMAX(0x114, 0xf); DPPMAX(0x118, 0xf);
    DPPMAX(0x142, 0xa); DPPMAX(0x143, 0xc);
#undef DPPMAX
    return __int_as_float(__builtin_amdgcn_readlane(__float_as_int(v), 63));
}
__device__ __forceinline__ void lds_fence() { asm volatile("s_waitcnt lgkmcnt(0)" ::: "memory"); }

#define LSTR 40

struct RawB16 { u32x4 v; __device__ __forceinline__ void st(bfr* base, int id) const { *(u32x4*)&base[(id >> 2) * LSTR + (id & 3) * 8] = v; } };
struct RawF32 { float v[8]; __device__ __forceinline__ uint4 pack() const { uint4 r; r.x = pack2(v[0], v[1]); r.y = pack2(v[2], v[3]); r.z = pack2(v[4], v[5]); r.w = pack2(v[6], v[7]); return r; } };
struct ALoadRows {
    typedef RawB16 Raw;
    const bfr* p[2];
    template <int BM> __device__ __forceinline__ void init(const bfr* base, int ld, int row0, int maxrow, const int* ridx) {
#pragma unroll
        for (int i = 0; i < BM * 4 / NTHR; ++i) {
            const int id = threadIdx.x + i * NTHR, r = id >> 2, kc = id & 3;
            int row = ridx ? ridx[r] : row0 + r;
            if (row > maxrow) row = maxrow;
            p[i] = base + (size_t)row * ld + kc * 8;
        }
    }
    __device__ __forceinline__ static void map(int id, int& r, int& kc) { r = id >> 2; kc = id & 3; }
    __device__ __forceinline__ void load(int i, int k0, Raw& r) const { r.v = *(const u32x4*)(p[i] + k0); }
};
struct BLoadT {
    typedef RawB16 Raw;
    static constexpr int DEPTH = 3;
    __device__ __forceinline__ static bf16x8 frag(const bfr* Bb, int wn, int ni, int ks, int lane) {
        return *(const bf16x8*)&Bb[(wn * 64 + ni * 32 + (lane & 31)) * LSTR + ks * 16 + (lane >> 5) * 8];
    }
    template <int BN> static constexpr int chunks() { return BN * 4 / NTHR; }
    const bfr* p[2];
    template <int BN> __device__ __forceinline__ void init(const bfr* base, int ld, int n0) {
#pragma unroll
        for (int i = 0; i < BN * 4 / NTHR; ++i) {
            const int id = threadIdx.x + i * NTHR, r = id >> 2, kc = id & 3;
            p[i] = base + (size_t)(n0 + r) * ld + kc * 8;
        }
    }
    __device__ __forceinline__ static void map(int id, int& r, int& kc) { r = id >> 2; kc = id & 3; }
    __device__ __forceinline__ void load(int i, int k0, Raw& r) const { r.v = *(const u32x4*)(p[i] + k0); }
};
#define KSTR 288
typedef short v4s16 __attribute__((ext_vector_type(4)));
struct RawF32Q {
    f32x4 v0, v1, v2, v3;
    __device__ __forceinline__ void st(bfr* base, int id) const {
        bfr* d = base + ((id >> 6) * 4) * KSTR + (id & 63) * 4;
        *(u32x2*)(d)            = (u32x2){pack2(v0.x, v0.y), pack2(v0.z, v0.w)};
        *(u32x2*)(d + KSTR)     = (u32x2){pack2(v1.x, v1.y), pack2(v1.z, v1.w)};
        *(u32x2*)(d + 2 * KSTR) = (u32x2){pack2(v2.x, v2.y), pack2(v2.z, v2.w)};
        *(u32x2*)(d + 3 * KSTR) = (u32x2){pack2(v3.x, v3.y), pack2(v3.z, v3.w)};
    }
};
template <int BN> struct BLoadF32 {
    typedef RawF32Q Raw;
    static constexpr int DEPTH = 2;
    __device__ __forceinline__ static bf16x8 frag(const bfr* Bb, int wn, int ni, int ks, int lane) {
        const int g = lane >> 4, q = (lane & 15) >> 2, pp = lane & 3;
        const bfr* a = Bb + (ks * 16 + 8 * (g >> 1) + q) * KSTR + wn * 64 + ni * 32 + 16 * (g & 1) + 4 * pp;
        union { v4s16 h[2]; bf16x8 v; } cv;
        cv.h[0] = __builtin_amdgcn_ds_read_tr16_b64_v4i16((v4s16 LAS*)a);
        cv.h[1] = __builtin_amdgcn_ds_read_tr16_b64_v4i16((v4s16 LAS*)(a + 4 * KSTR));
        return cv.v;
    }
    template <int BN_> static constexpr int chunks() { return BN_ * 32 / 16 / NTHR; }
    const float* p[2]; int ldn;
    __device__ __forceinline__ void load(int i, int k0, Raw& r) const {
        const float* q = p[i] + (size_t)k0 * ldn;
        r.v0 = *(const f32x4*)(q); r.v1 = *(const f32x4*)(q + (size_t)ldn); r.v2 = *(const f32x4*)(q + (size_t)2 * ldn); r.v3 = *(const f32x4*)(q + (size_t)3 * ldn);
    }
};

#define GD 3
template <class L, int N> struct GSlot {
    typename L::Raw r0, r1;
    __device__ __forceinline__ void load(const L& l, int k0) { l.load(0, k0, r0); if constexpr (N > 1) l.load(1, k0, r1); }
    __device__ __forceinline__ void store(bfr* base, int tid) const { r0.st(base, tid); if constexpr (N > 1) r1.st(base, tid + NTHR); }
};
template <int BM, int BN, int K, class AL, class BL>
struct GemmPipe {
    static constexpr int WN = BN / 64;
    static constexpr int ACH = BM * 4 / NTHR, BCH = BL::template chunks<BN>();
    static constexpr int nk = K / 32;
    static constexpr int ASZ = BM * LSTR, BSZ = BN * LSTR;
    GSlot<AL, ACH> sa0, sa1, sa2;
    GSlot<BL, BCH> sb0, sb1, sb2;
    f32x16 acc[2][2];
#define G_LOAD(SA, SB, KT) do { SA.load(al, (KT) * 32); SB.load(bl, (KT) * 32); } while (0)
    __device__ __forceinline__ void prefetch(const AL& al, const BL& bl) {
        G_LOAD(sa0, sb0, 0);
        if (1 < nk) G_LOAD(sa1, sb1, 1);
        if constexpr (BL::DEPTH == 3) { if (2 < nk) G_LOAD(sa2, sb2, 2); }
        __builtin_amdgcn_sched_barrier(0);
    }
    __device__ __forceinline__ void mainloop(bfr* smem, const AL& al, const BL& bl) {
        const int tid = threadIdx.x, lane = tid & 63, wave = tid >> 6;
        const int wm = wave / WN, wn = wave % WN;
        bfr* As = smem;
        bfr* Bs3 = smem + 3 * ASZ;
#pragma unroll
        for (int i = 0; i < 2; ++i)
#pragma unroll
            for (int j = 0; j < 2; ++j)
#pragma unroll
                for (int r = 0; r < 16; ++r) acc[i][j][r] = 0.f;
        bf16x8 fa0[2][2], fb0[2][2], fa1[2][2], fb1[2][2];
#define G_STORE(SA, SB, BUF) do { SA.store(As + (BUF) * ASZ, tid); SB.store(Bs3 + (BUF) * BSZ, tid); } while (0)
#define G_RD(FA, FB, BUF) do { \
        const bfr* Ab = As + (BUF) * ASZ + (wm * 64 + (lane & 31)) * LSTR + (lane >> 5) * 8; \
        _Pragma("unroll") for (int ks = 0; ks < 2; ++ks) { \
            _Pragma("unroll") for (int mi = 0; mi < 2; ++mi) FA[ks][mi] = *(const bf16x8*)&Ab[mi * 32 * LSTR + ks * 16]; \
            _Pragma("unroll") for (int ni = 0; ni < 2; ++ni) FB[ks][ni] = BL::frag(Bs3 + (BUF) * BSZ, wn, ni, ks, lane); } } while (0)
#define G_MM(FA, FB) do { \
        _Pragma("unroll") for (int ks = 0; ks < 2; ++ks) \
            _Pragma("unroll") for (int mi = 0; mi < 2; ++mi) \
                _Pragma("unroll") for (int ni = 0; ni < 2; ++ni) \
                    acc[mi][ni] = __builtin_amdgcn_mfma_f32_32x32x16_bf16(FA[ks][mi], FB[ks][ni], acc[mi][ni], 0, 0, 0); } while (0)
#define G_STEP(J, FAC, FBC, FAN, FBN, RBUF, SA, SB, WBUF, DEP) do { const int k = kt + (J); if (k < nk) { \
        if (k + 1 < nk) G_RD(FAN, FBN, RBUF); \
        if (k + 2 < nk) { G_STORE(SA, SB, WBUF); if (k + 2 + (DEP) < nk) { G_LOAD(SA, SB, k + 2 + (DEP)); __builtin_amdgcn_sched_barrier(0); } } \
        G_MM(FAC, FBC); \
        __syncthreads(); } } while (0)
        __syncthreads();
        G_STORE(sa0, sb0, 0);
        if (1 < nk) G_STORE(sa1, sb1, 1);
        if (BL::DEPTH < nk) G_LOAD(sa0, sb0, BL::DEPTH);
        if (BL::DEPTH + 1 < nk) G_LOAD(sa1, sb1, BL::DEPTH + 1);
        __builtin_amdgcn_sched_barrier(0);
        __syncthreads();
        G_RD(fa0, fb0, 0);
        if constexpr (BL::DEPTH == 3) {
#pragma unroll
            for (int kt = 0; kt < nk; kt += 6) {
                G_STEP(0, fa0, fb0, fa1, fb1, 1, sa2, sb2, 2, 3);
                G_STEP(1, fa1, fb1, fa0, fb0, 2, sa0, sb0, 0, 3);
                G_STEP(2, fa0, fb0, fa1, fb1, 0, sa1, sb1, 1, 3);
                G_STEP(3, fa1, fb1, fa0, fb0, 1, sa2, sb2, 2, 3);
                G_STEP(4, fa0, fb0, fa1, fb1, 2, sa0, sb0, 0, 3);
                G_STEP(5, fa1, fb1, fa0, fb0, 0, sa1, sb1, 1, 3);
            }
        } else {
#pragma unroll
            for (int kt = 0; kt < nk; kt += 6) {
                G_STEP(0, fa0, fb0, fa1, fb1, 1, sa0, sb0, 2, 2);
                G_STEP(1, fa1, fb1, fa0, fb0, 2, sa1, sb1, 0, 2);
                G_STEP(2, fa0, fb0, fa1, fb1, 0, sa0, sb0, 1, 2);
                G_STEP(3, fa1, fb1, fa0, fb0, 1, sa1, sb1, 2, 2);
                G_STEP(4, fa0, fb0, fa1, fb1, 2, sa0, sb0, 0, 2);
                G_STEP(5, fa1, fb1, fa0, fb0, 0, sa1, sb1, 1, 2);
            }
        }
#undef G_STORE
#undef G_RD
#undef G_MM
#undef G_STEP
    }
#undef G_LOAD
    template <class EP> __device__ __forceinline__ void epilogue(bfr* smem, EP& ep) {
        const int lane = threadIdx.x & 63, wave = threadIdx.x >> 6;
        const int wm = wave / WN, wn = wave % WN;
        if (ep.direct()) {
#pragma unroll
            for (int mi = 0; mi < 2; ++mi)
#pragma unroll
                for (int ni = 0; ni < 2; ++ni) ep.tile(acc[mi][ni], wm * 64 + mi * 32, wn * 64 + ni * 32, lane, mi, ni);
        } else {
            constexpr int CSTR = BN + 4;
            float* Ct = (float*)smem;
#pragma unroll
            for (int mi = 0; mi < 2; ++mi)
#pragma unroll
                for (int ni = 0; ni < 2; ++ni)
#pragma unroll
                    for (int q = 0; q < 16; ++q)
                        Ct[(wm * 64 + mi * 32 + (q & 3) + 8 * (q >> 2) + 4 * (lane >> 5)) * CSTR + wn * 64 + ni * 32 + (lane & 31)] = acc[mi][ni][q];
            __syncthreads();
            ep.template rows<BM, BN>(Ct, CSTR);
        }
    }
};
constexpr int GEMM_SMEM_ELEMS = 2 * (256 + 128) * LSTR;
constexpr int MOE_TAB_OFF = 133632;

template <int FRAG = 0>
__device__ __forceinline__ void transpose_cvt(const float* W, int K, int N, bfr* WT, int bid, int nb) {
    const size_t total = (size_t)N * (K / 8);
#pragma unroll 1
    for (size_t i = (size_t)bid * NTHR + threadIdx.x; i < total; i += (size_t)nb * NTHR) {
        const int n = (int)(i % N), kc = (int)(i / N);
        float v[8];
#pragma unroll
        for (int j = 0; j < 8; ++j) v[j] = W[(size_t)(kc * 8 + j) * N + n];
        uint4 r; r.x = pack2(v[0], v[1]); r.y = pack2(v[2], v[3]); r.z = pack2(v[4], v[5]); r.w = pack2(v[6], v[7]);
        if (FRAG) *(uint4*)&WT[((size_t)((kc >> 1) * (N / 32) + (n >> 5)) * 64 + (n & 31) + 32 * (kc & 1)) * 8] = r;
        else *(uint4*)&WT[(size_t)n * K + kc * 8] = r;
    }
}

__device__ __forceinline__ void hyena_filter_task(const Params& P, float* sm, int task, int probe = 0) {
    const bool isctx = task >= 512;
    const int l = isctx ? NCTX : LSEQ;
    const int p0 = (isctx ? task - 512 : task) * 32;
    const float* w1 = P.in[15]; const float* b1 = P.in[16]; const float* fq = P.in[17];
    const float* w2 = P.in[18]; const float* b2 = P.in[19]; const float* w3 = P.in[20];
    float* zemb = sm;
    float* h1 = sm + 32 * 33;
    float* h2 = h1 + 32 * 64;
    const int tid = threadIdx.x;
    __syncthreads();
    for (int e = tid; e < 32 * 33; e += NTHR) {
        const int pp = e / 33, i = e % 33;
        const float pos = (float)(p0 + pp);
        float v;
        if (i == 0) v = pos / (float)(l - 1);
        else {
            const int b = (i - 1) & 15;
            const float band = 1e-4f + (float)b * ((15.f - 1e-4f) / 15.f);
            const float ang = ((float)(2.0 * 3.14159265358979323846 / (double)l) * pos) * band;
            v = (i <= 16) ? cosf(ang) : -sinf(ang);
        }
        zemb[e] = v;
    }
    __syncthreads();
    for (int e = tid; e < 32 * 64; e += NTHR) {
        const int pp = e >> 6, j = e & 63;
        float s = b1[j];
#pragma unroll 4
        for (int i = 0; i < 33; ++i) s += zemb[pp * 33 + i] * w1[i * 64 + j];
        h1[e] = sinf(fq[j] * s);
    }
    __syncthreads();
    for (int e = tid; e < 32 * 64; e += NTHR) {
        const int pp = e >> 6, j = e & 63;
        float s = b2[j];
#pragma unroll 4
        for (int i = 0; i < 64; ++i) s += h1[pp * 64 + i] * w2[i * 64 + j];
        h2[e] = sinf(fq[j] * s);
    }
    __syncthreads();
    const float lo = -4.605170185988091f / 1.5f, hi = -4.605170185988091f / 0.3f;
    const float delta = fabsf(lo + (float)tid * ((hi - lo) / 511.f));
    float* HF = isctx ? (float*)(P.ws + WS_HFC) + (size_t)tid * 512 + 256 : (float*)(P.ws + WS_HF) + (size_t)tid * 32768 + LSEQ;
    float asum = 0.f;
#pragma unroll 1
    for (int hp = 0; hp < 2; ++hp) {
        float accf[16], accb[16];
#pragma unroll
        for (int i = 0; i < 16; ++i) { accf[i] = 0.f; accb[i] = 0.f; }
#pragma unroll 2
        for (int k = 0; k < 64; ++k) {
            const float wf = w3[k * 1024 + tid], wb = w3[k * 1024 + 512 + tid];
#pragma unroll
            for (int pp = 0; pp < 16; ++pp) { const float h = h2[(hp * 16 + pp) * 64 + k]; accf[pp] += h * wf; accb[pp] += h * wb; }
        }
#pragma unroll
        for (int pp = 0; pp < 16; ++pp) {
            const int pos = p0 + hp * 16 + pp;
            const float t = (float)pos / (float)(l - 1);
            const float win = expf(-t * delta);
            const float f = accf[pp] * win, b = accb[pp] * win;
            HF[pos] = f; asum += fabsf(f);
            if (pos >= 1) { HF[-pos] = b; asum += fabsf(b); }
        }
    }
    ((float*)(P.ws + WS_NORMP))[(size_t)tid * 520 + task] = asum;
}

__device__ __forceinline__ void phase_prologue(const Params& P, float* sm, int bid, int nb, int probe = 0) {
    const int tid = threadIdx.x;
    for (int rep2 = (PROBE_DUP == 101 ? 0 : 1); rep2 < 2; ++rep2) {
    for (int task = bid; task < 192; task += nb) {
        const int layer = task / 96, j0 = (task % 96) * 64;
        float* sv = sm;
        float* red = sm + 2048;
        __syncthreads();
        for (int e = tid; e < 2048; e += NTHR) { const float c = (e < 1024) ? P.in[3][e] : P.in[1][e - 1024]; sv[e] = siluf_(c); }
        __syncthreads();
        const int jj = tid & 63, ks = tid >> 6;
        const float* w = P.in[4] + (size_t)layer * 1024 * 6144 + j0 + jj;
        float a0 = 0.f, a1 = 0.f;
#pragma unroll 8
        for (int k = ks * 128; k < ks * 128 + 128; ++k) { const float wv = w[(size_t)k * 6144]; a0 += sv[k] * wv; a1 += sv[1024 + k] * wv; }
        red[(ks * 64 + jj) * 2] = a0; red[(ks * 64 + jj) * 2 + 1] = a1;
        __syncthreads();
        if (tid < 128) {
            const int j = tid & 63, wh = tid >> 6;
            float s = 0.f;
            for (int q = 0; q < 8; ++q) s += red[(q * 64 + j) * 2 + wh];
            ((float*)(P.ws + WS_MOD))[(size_t)(layer * 2 + wh) * 6144 + j0 + j] = s + P.in[5][layer * 6144 + j0 + j];
        }
    }
    transpose_cvt(P.in[10], 1024, 3072, (bfr*)(P.ws + WS_WINT0), bid, nb);
    transpose_cvt(P.in[11], 1024, 1024, (bfr*)(P.ws + WS_WOUTT0), bid, nb);
    transpose_cvt(P.in[22], 1024, 1280, (bfr*)(P.ws + WS_WINT1), bid, nb);
    transpose_cvt(P.in[23], 1024, 1024, (bfr*)(P.ws + WS_WOUTT1), bid, nb);
    transpose_cvt<1>(P.in[36], 1024, 256, (bfr*)(P.ws + WS_ROUT), bid, nb);
    transpose_cvt<1>(P.in[36] + 1024 * 256, 1024, 256, (bfr*)(P.ws + WS_ROUT) + 256 * 1024, bid, nb);
    transpose_cvt(P.in[34], 512, 512, (bfr*)(P.ws + WS_GLUT), bid, nb);
    }
    for (int rep = (PROBE_DUP == 100 ? 0 : 1); rep < 2; ++rep)
        for (int task = bid; task < 520; task += nb) hyena_filter_task(P, sm, task, rep == 0 ? 1 : 0);
    for (int i = bid * NTHR + tid; i < 4096; i += nb * NTHR) {
        const int dg = i >> 6, p = i & 63;
        const float are = P.in[26][i], aim = P.in[27][i];
        const float dt = expf(P.in[28][dg]);
        const float mag = expf(are * dt);
        const float abr = mag * cosf(aim * dt), abi = mag * sinf(aim * dt);
        ((float2*)(P.ws + WS_ABAR))[i] = make_float2(abr, abi);
        float xr = abr, xi = abi;
#pragma unroll
        for (int q = 0; q < 6; ++q) { const float nr = xr * xr - xi * xi, ni = 2.f * xr * xi; xr = nr; xi = ni; }
        ((float2*)(P.ws + WS_A64))[i] = make_float2(xr, xi);
        const float nr = abr - 1.f, ni = abi, den = are * are + aim * aim;
        const float cr = (nr * are + ni * aim) / den, ci = (ni * are - nr * aim) / den;
        float2* bb = (float2*)(P.ws + WS_BBAR) + (size_t)i * 16;
#pragma unroll 4
        for (int k = 0; k < 16; ++k) {
            const float br = P.in[29][(size_t)i * 16 + k], bi = P.in[30][(size_t)i * 16 + k];
            bb[k] = make_float2(cr * br - ci * bi, cr * bi + ci * br);
        }
        bfr* cm = (bfr*)(P.ws + WS_CMAT) + (size_t)dg * 16 * 128;
#pragma unroll 4
        for (int n = 0; n < 16; ++n) {
            const float c_re = P.in[31][((size_t)dg * 16 + n) * 64 + p], c_im = P.in[32][((size_t)dg * 16 + n) * 64 + p];
            cm[n * 128 + 2 * p] = f2bf(c_re); cm[n * 128 + 2 * p + 1] = f2bf(-c_im);
        }
    }
}

__device__ __forceinline__ void phase_h0(const Params& P, int bid, int nb) {
    const float* mod = (const float*)(P.ws + WS_MOD);
    bfr* H = (bfr*)(P.ws + WS_H);
    const size_t total = (size_t)NT * 128;
    for (size_t i = (size_t)bid * NTHR + threadIdx.x; i < total; i += (size_t)nb * NTHR) {
        const int row = (int)(i >> 7), c0 = (int)(i & 127) * 8;
        const int wh = row >= NCTX;
        const float* src = wh ? P.in[0] + (size_t)(row - NCTX) * 1024 + c0 : P.in[2] + (size_t)row * 1024 + c0;
        const float* sh = mod + (size_t)wh * 6144 + c0;
        const float* sc = sh + 1024;
        const float4 a = *(const float4*)src, b = *(const float4*)(src + 4);
        const float4 s0 = *(const float4*)sc, s1 = *(const float4*)(sc + 4);
        const float4 h0 = *(const float4*)sh, h1 = *(const float4*)(sh + 4);
        uint4 r;
        r.x = pack2(a.x * (1.f + s0.x) + h0.x, a.y * (1.f + s0.y) + h0.y);
        r.y = pack2(a.z * (1.f + s0.z) + h0.z, a.w * (1.f + s0.w) + h0.w);
        r.z = pack2(b.x * (1.f + s1.x) + h1.x, b.y * (1.f + s1.y) + h1.y);
        r.w = pack2(b.z * (1.f + s1.z) + h1.z, b.w * (1.f + s1.w) + h1.w);
        *(uint4*)&H[(size_t)row * 1024 + c0] = r;
    }
}

#define ROWS_LOOP(BM_, BN_) for (int id_ = threadIdx.x; id_ < (BM_) * (BN_) / 8; id_ += NTHR)
__device__ __forceinline__ void ld8(const float* p, float* v) {
    const float4 a = *(const float4*)p, b = *(const float4*)(p + 4);
    v[0] = a.x; v[1] = a.y; v[2] = a.z; v[3] = a.w; v[4] = b.x; v[5] = b.y; v[6] = b.z; v[7] = b.w;
}
__device__ __forceinline__ void up8(const uint4 v, float* f) {
    f[0] = bflo(v.x); f[1] = bfhi(v.x); f[2] = bflo(v.y); f[3] = bfhi(v.y); f[4] = bflo(v.z); f[5] = bfhi(v.z); f[6] = bflo(v.w); f[7] = bfhi(v.w);
}
__device__ __forceinline__ uint4 pack8(const float* v) { uint4 r; r.x = pack2(v[0], v[1]); r.y = pack2(v[2], v[3]); r.z = pack2(v[4], v[5]); r.w = pack2(v[6], v[7]); return r; }

struct EpiBf16 {
    bfr* C; int ld; int row0, col0, maxrow;
    __device__ __forceinline__ bool direct() const { return false; }
    __device__ __forceinline__ void tile(const f32x16&, int, int, int, int, int) {}
    template <int BM, int BN> __device__ __forceinline__ void rows(const float* Ct, int cstr) {
        ROWS_LOOP(BM, BN) {
            const int r = id_ / (BN / 8), c = (id_ % (BN / 8)) * 8;
            const int row = row0 + r;
            float v[8]; ld8(Ct + r * cstr + c, v);
            if (row <= maxrow) *(uint4*)&C[(size_t)row * ld + col0 + c] = pack8(v);
        }
    }
};
__device__ __forceinline__ void phase_gemm_bf16out(const bfr* A, int lda, int m0, int M, const bfr* Bt, int N, int K, bfr* C, int ldc, bfr* smem, int bid, int nb) {
    const int mt = (M + 255) / 256, nt = N / 128, nu = mt * nt;
    GemmPipe<256, 128, 1024, ALoadRows, BLoadT> gp;
    ALoadRows al; BLoadT bl;
    int u = bid;
    if (u < nu) { al.init<256>(A, lda, m0 + (u / nt) * 256, m0 + M - 1, nullptr); bl.init<128>(Bt, K, (u % nt) * 128); gp.prefetch(al, bl); }
    while (u < nu) {
        EpiBf16 ep{C, ldc, m0 + (u / nt) * 256, (u % nt) * 128, m0 + M - 1};
        gp.mainloop(smem, al, bl);
        const int un = u + nb;
        if (un < nu) { al.init<256>(A, lda, m0 + (un / nt) * 256, m0 + M - 1, nullptr); bl.init<128>(Bt, K, (un % nt) * 128); gp.prefetch(al, bl); }
        gp.epilogue(smem, ep);
        u = un;
    }
}
struct EpiInProj0 {
    bfr* C; bfr* VT; bfr* KF; int row0, col0;
    __device__ __forceinline__ bool direct() const { return col0 >= 1024 && col0 < 1536; }
    __device__ __forceinline__ void tile(const f32x16& a, int rb, int cb, int lane, int, int) {
        const int colv = col0 + cb + (lane & 31) - 1024;
        const int head = colv >> 6, dt = (colv >> 5) & 1, r = colv & 31;
#pragma unroll
        for (int g4 = 0; g4 < 4; ++g4) {
            const int t0 = row0 + rb + 8 * g4 + 4 * (lane >> 5);
            const int kb = t0 >> 4, pos0 = t0 & 15;
            uint2 pk; pk.x = pack2(a[g4 * 4], a[g4 * 4 + 1]); pk.y = pack2(a[g4 * 4 + 2], a[g4 * 4 + 3]);
            *(uint2*)&VT[((((size_t)head * (NT / 16) + kb) * 2 + dt) * 64 + r + 32 * ((pos0 >> 2) & 1)) * 8 + (pos0 >> 3) * 4] = pk;
        }
    }
    template <int BM, int BN> __device__ __forceinline__ void rows(const float* Ct, int cstr) {
        ROWS_LOOP(BM, BN) {
            const int r = id_ / (BN / 8), c = (id_ % (BN / 8)) * 8;
            float v[8]; ld8(Ct + r * cstr + c, v);
            const int t = row0 + r, col = col0 + c;
            if (col0 >= 512 && col0 < 1024) {
                const int colk = col - 512, head = colk >> 6, dd0 = colk & 63;
                *(uint4*)&KF[((((size_t)head * (NT / 32) + (t >> 5)) * 4 + (dd0 >> 4)) * 64 + (t & 31) + 32 * ((dd0 >> 3) & 1)) * 8] = pack8(v);
            } else *(uint4*)&C[(size_t)t * 3072 + col] = pack8(v);
        }
    }
};
__device__ __forceinline__ void phase_inproj0(const Params& P, bfr* smem, int bid, int nb) {
    const bfr* A = (const bfr*)(P.ws + WS_H);
    const bfr* Bt = (const bfr*)(P.ws + WS_WINT0);
    constexpr int nu = 65 * 24;
    GemmPipe<256, 128, 1024, ALoadRows, BLoadT> gp;
    ALoadRows al; BLoadT bl;
    int u = bid;
    if (u < nu) { al.init<256>(A, 1024, (u / 24) * 256, NT - 1, nullptr); bl.init<128>(Bt, 1024, (u % 24) * 128); gp.prefetch(al, bl); }
    while (u < nu) {
        EpiInProj0 ep{(bfr*)(P.ws + WS_QKVU), (bfr*)(P.ws + WS_VT0), (bfr*)(P.ws + WS_K0F), (u / 24) * 256, (u % 24) * 128};
        gp.mainloop(smem, al, bl);
        const int un = u + nb;
        if (un < nu) { al.init<256>(A, 1024, (un / 24) * 256, NT - 1, nullptr); bl.init<128>(Bt, 1024, (un % 24) * 128); gp.prefetch(al, bl); }
        gp.epilogue(smem, ep);
        u = un;
    }
}
struct EpiOutProj {
    const float* xc; const float* xl; const bfr* x2; const float* mod; bfr* PRE; int row0, col0;
    __device__ __forceinline__ bool direct() const { return false; }
    __device__ __forceinline__ void tile(const f32x16&, int, int, int, int, int) {}
    template <int BM, int BN> __device__ __forceinline__ void rows(const float* Ct, int cstr) {
        ROWS_LOOP(BM, BN) {
            const int r = id_ / (BN / 8), c = (id_ % (BN / 8)) * 8;
            const int row = row0 + r, col = col0 + c;
            if (row < NT) {
                const int wh = row >= NCTX;
                float v[8], x[8], g[8]; ld8(Ct + r * cstr + c, v);
                if (x2) {
                    const uint4 xx = *(const uint4*)(x2 + (size_t)row * 1024 + col);
                    x[0] = bflo(xx.x); x[1] = bfhi(xx.x); x[2] = bflo(xx.y); x[3] = bfhi(xx.y); x[4] = bflo(xx.z); x[5] = bfhi(xx.z); x[6] = bflo(xx.w); x[7] = bfhi(xx.w);
                } else ld8(wh ? xl + (size_t)(row - NCTX) * 1024 + col : xc + (size_t)row * 1024 + col, x);
                ld8(mod + (size_t)wh * 6144 + 2048 + col, g);
#pragma unroll
                for (int j = 0; j < 8; ++j) v[j] = ALPHA * x[j] + g[j] * v[j];
                *(uint4*)(PRE + (size_t)row * 1024 + col) = pack8(v);
            }
        }
    }
};
__device__ __forceinline__ void phase_outproj(const Params& P, int layer, bfr* smem, int bid, int nb) {
    const bfr* A = (const bfr*)(P.ws + WS_ATT);
    const bfr* Bt = (const bfr*)(P.ws + (layer ? WS_WOUTT1 : WS_WOUTT0));
    const float* mod = (const float*)(P.ws + WS_MOD) + (size_t)layer * 2 * 6144;
    const float* xc = P.in[2];
    const float* xl = P.in[0];
    const bfr* x2 = layer ? (const bfr*)(P.ws + WS_X2) : nullptr;
    const int m0 = layer ? NCTX : 0, M = NT - m0;
    const int mt = (M + 255) / 256, nu = mt * 8;
    GemmPipe<256, 128, 1024, ALoadRows, BLoadT> gp;
    ALoadRows al; BLoadT bl;
    int u = bid;
    if (u < nu) { al.init<256>(A, 1024, m0 + (u >> 3) * 256, NT - 1, nullptr); bl.init<128>(Bt, 1024, (u & 7) * 128); gp.prefetch(al, bl); }
    while (u < nu) {
        EpiOutProj ep{xc, xl, x2, mod, (bfr*)(P.ws + WS_PRE), m0 + (u >> 3) * 256, (u & 7) * 128};
        gp.mainloop(smem, al, bl);
        const int un = u + nb;
        if (un < nu) { al.init<256>(A, 1024, m0 + (un >> 3) * 256, NT - 1, nullptr); bl.init<128>(Bt, 1024, (un & 7) * 128); gp.prefetch(al, bl); }
        gp.epilogue(smem, ep);
        u = un;
    }
}

__device__ __forceinline__ void phase_na_attention(const Params& P, float* sm, int bid, int nb) {
    const bfr* QK = (const bfr*)(P.ws + WS_QKVU);
    const bfr* VT = (const bfr*)(P.ws + WS_VT0);
    const bfr* KF = (const bfr*)(P.ws + WS_K0F);
    bfr* ATT = (bfr*)(P.ws + WS_ATT);
    const float* rpb = P.in[12];
    const int lane = threadIdx.x & 63, wave = threadIdx.x >> 6, r = lane & 31, h = lane >> 5;
    const float SC = 0.125f * 1.4426950408889634f, L2E = 1.4426950408889634f;
    __syncthreads();
    for (int e = threadIdx.x; e < 8 * 15 * 31; e += NTHR) sm[e] = P.in[12][e] * L2E;
    __syncthreads();
    for (int task = bid * 8 + wave; task < 260 * 16; task += nb * 8) {
        const int qh = task & 1, head = (task >> 1) & 7, blk = task >> 4;
        const bool lat = blk >= 4;
        const int rr = blk - 4;
        const int tok = blk * 64 + qh * 32 + r;
        const int c = qh * 32 + r;
        const int cs = min(max(c - 8, 0), 48), rs = min(max(rr - 4, 0), 248);
        bf16x8 qf[4];
#pragma unroll
        for (int ks = 0; ks < 4; ++ks) qf[ks] = *(const bf16x8*)(QK + (size_t)tok * 3072 + head * 64 + ks * 16 + h * 8);
        f32x16 o[2];
#pragma unroll
        for (int i = 0; i < 2; ++i)
#pragma unroll
            for (int q = 0; q < 16; ++q) o[i][q] = 0.f;
        float m = -1e30f, l = 0.f;
        const int ntiles = lat ? 12 : 4;
        bf16x8 kf[2][4];
        {
            const int krow0 = lat ? NCTX + rs * 64 : 0;
#pragma unroll
            for (int kt = 0; kt < 2; ++kt)
#pragma unroll
                for (int ks = 0; ks < 4; ++ks) kf[kt][ks] = *(const bf16x8*)(KF + ((((size_t)head * (NT / 32) + (krow0 >> 5) + kt) * 4 + ks) * 64 + lane) * 8);
        }
        for (int ti = 0; ti < ntiles; ++ti) {
            const bool win = lat && ti < 8;
            const int krow0 = win ? NCTX + (rs + ti) * 64 : (lat ? ti - 8 : ti) * 64;
            bf16x8 vfr[2][2][2];
#pragma unroll
            for (int dt = 0; dt < 2; ++dt)
#pragma unroll
                for (int kt = 0; kt < 2; ++kt)
#pragma unroll
                    for (int s2 = 0; s2 < 2; ++s2)
                        vfr[dt][kt][s2] = *(const bf16x8*)(VT + ((((size_t)head * (NT / 16) + (krow0 >> 4) + kt * 2 + s2) * 2 + dt) * 64 + lane) * 8);
            f32x16 s[2];
#pragma unroll
            for (int kt = 0; kt < 2; ++kt) {
#pragma unroll
                for (int q = 0; q < 16; ++q) s[kt][q] = 0.f;
#pragma unroll
                for (int ks = 0; ks < 4; ++ks) s[kt] = __builtin_amdgcn_mfma_f32_32x32x16_bf16(kf[kt][ks], qf[ks], s[kt], 0, 0, 0);
            }
            if (ti + 1 < ntiles) {
                const bool win1 = lat && ti + 1 < 8;
                const int krow1 = win1 ? NCTX + (rs + ti + 1) * 64 : (lat ? ti + 1 - 8 : ti + 1) * 64;
#pragma unroll
                for (int kt = 0; kt < 2; ++kt)
#pragma unroll
                    for (int ks = 0; ks < 4; ++ks) kf[kt][ks] = *(const bf16x8*)(KF + ((((size_t)head * (NT / 32) + (krow1 >> 5) + kt) * 4 + ks) * 64 + lane) * 8);
            }
            if (win) {
                const float* rp = sm + (head * 15 + (rs + ti - rr + 7)) * 31 - c + 15;
#pragma unroll
                for (int kt = 0; kt < 2; ++kt)
#pragma unroll
                    for (int q = 0; q < 16; ++q) {
                        const int kc = kt * 32 + (q & 3) + 8 * (q >> 2) + 4 * h;
                        const bool in = (kc >= cs) && (kc < cs + 16);
                        const float bias = rp[in ? kc : c];
                        s[kt][q] = in ? s[kt][q] * SC + bias : -1e30f;
                    }
            } else {
#pragma unroll
                for (int kt = 0; kt < 2; ++kt)
#pragma unroll
                    for (int q = 0; q < 16; ++q) s[kt][q] *= SC;
            }
            float mx = s[0][0];
#pragma unroll
            for (int q = 1; q < 16; ++q) mx = fmaxf(mx, s[0][q]);
#pragma unroll
            for (int q = 0; q < 16; ++q) mx = fmaxf(mx, s[1][q]);
            mx = fmaxf(mx, __shfl_xor(mx, 32, 64));
            const float mn = fmaxf(m, mx);
            const float alpha = __builtin_amdgcn_exp2f(m - mn);
            l *= alpha;
#pragma unroll
            for (int q = 0; q < 16; ++q) { o[0][q] *= alpha; o[1][q] *= alpha; }
            m = mn;
            bf16x8 pf[2][2];
#pragma unroll
            for (int kt = 0; kt < 2; ++kt)
#pragma unroll
                for (int s2 = 0; s2 < 2; ++s2) {
                    float pv[8];
#pragma unroll
                    for (int j = 0; j < 8; ++j) { pv[j] = __builtin_amdgcn_exp2f(s[kt][s2 * 8 + j] - m); l += pv[j]; }
                    union { uint4 u; bf16x8 v; } cv;
                    cv.u.x = pack2(pv[0], pv[1]); cv.u.y = pack2(pv[2], pv[3]); cv.u.z = pack2(pv[4], pv[5]); cv.u.w = pack2(pv[6], pv[7]);
                    pf[kt][s2] = cv.v;
                }
#pragma unroll
            for (int dt = 0; dt < 2; ++dt)
#pragma unroll
                for (int kt = 0; kt < 2; ++kt)
#pragma unroll
                    for (int s2 = 0; s2 < 2; ++s2)
                        o[dt] = __builtin_amdgcn_mfma_f32_32x32x16_bf16(vfr[dt][kt][s2], pf[kt][s2], o[dt], 0, 0, 0);
        }
        l += __shfl_xor(l, 32, 64);
        const float inv = 1.f / l;
        bfr* op = ATT + (size_t)tok * 1024 + head * 64;
#pragma unroll
        for (int dt = 0; dt < 2; ++dt)
#pragma unroll
            for (int g4 = 0; g4 < 4; ++g4) {
                uint2 pk;
                pk.x = pack2(o[dt][g4 * 4 + 0] * inv, o[dt][g4 * 4 + 1] * inv);
                pk.y = pack2(o[dt][g4 * 4 + 2] * inv, o[dt][g4 * 4 + 3] * inv);
                *(uint2*)(op + dt * 32 + g4 * 8 + h * 4) = pk;
            }
    }
}

__device__ __forceinline__ float short_conv(const bfr* QK, const float* cw, const float* cb, int row, int cc, int seg0, int seg1) {
    const bfr* u = QK + (size_t)row * 3072 + 1536 + cc;
    float s = cb[cc] + bf2f(u[0]) * cw[1536 + cc];
    if (row - 1 >= seg0) s += bf2f(u[-3072]) * cw[cc];
    if (row + 1 < seg1) s += bf2f(u[3072]) * cw[2 * 1536 + cc];
    return s;
}

__device__ __forceinline__ void phase_zprep(const Params& P, float* sm, int bid, int nb) {
    const bfr* QK = (const bfr*)(P.ws + WS_QKVU);
    float* Z = (float*)(P.ws + WS_Z);
    float* X0 = (float*)(P.ws + WS_X0);
    const float* cw = P.in[13]; const float* cb = P.in[14];
    const int tid = threadIdx.x;
    float* sz = sm; float* sx = sm + 512 * 33;
    float w0[3], w1[3], w2[3], bs[3];
#pragma unroll
    for (int g = 0; g < 3; ++g) { const int cc = g * 512 + tid; w0[g] = cw[cc]; w1[g] = cw[1536 + cc]; w2[g] = cw[2 * 1536 + cc]; bs[g] = cb[cc]; }
    for (int u = bid; u < NT / 32; u += nb) {
        const int r0 = u * 32;
        const int seg0 = r0 < NCTX ? 0 : NCTX, seg1 = r0 < NCTX ? NCTX : NT;
        const bfr* up = QK + (size_t)r0 * 3072 + 1536 + tid;
        float pv[3], cv[3];
#pragma unroll
        for (int g = 0; g < 3; ++g) { pv[g] = (r0 - 1 >= seg0) ? bf2f(up[g * 512 - 3072]) : 0.f; cv[g] = bf2f(up[g * 512]); }
        __syncthreads();
#pragma unroll 8
        for (int tt = 0; tt < 32; ++tt) {
            float nv[3], y[3];
#pragma unroll
            for (int g = 0; g < 3; ++g) {
                nv[g] = (r0 + tt + 1 < seg1) ? bf2f(up[(size_t)(tt + 1) * 3072 + g * 512]) : 0.f;
                y[g] = bs[g] + pv[g] * w0[g] + cv[g] * w1[g] + nv[g] * w2[g];
                pv[g] = cv[g]; cv[g] = nv[g];
            }
            sz[tid * 33 + tt] = y[1] * y[2];
            sx[tid * 33 + tt] = y[0];
        }
        __syncthreads();
        for (int e = tid; e < 512 * 32; e += NTHR) {
            const int c = e >> 5, tt = e & 31;
            Z[(size_t)c * NT + r0 + tt] = sz[c * 33 + tt];
            X0[(size_t)c * NT + r0 + tt] = sx[c * 33 + tt];
        }
    }
}

#define HZ_STR 136
#define HC_LEN 2208
__device__ __forceinline__ void phase_longconv(const Params& P, unsigned char* smraw, int bid, int nb) {
    const bfr* QK = (const bfr*)(P.ws + WS_QKVU);
    const float* Z = (const float*)(P.ws + WS_Z);
    const float* HF = (const float*)(P.ws + WS_HF);
    const float* HFC = (const float*)(P.ws + WS_HFC);
    const float* X0 = (const float*)(P.ws + WS_X0);
    const float* cw = P.in[13]; const float* cb = P.in[14]; const float* skip = P.in[21];
    bfr* ATT = (bfr*)(P.ws + WS_ATT);
    const int tid = threadIdx.x, lane = tid & 63, wave = tid >> 6, r = lane & 31, h = lane >> 5;
    {
        bfr* Zs = (bfr*)smraw;
        bfr* Cs = Zs + 129 * HZ_STR;
        float* Red = (float*)smraw;
        const int bh = wave & 1, kh = (wave >> 1) & 1, ah = wave >> 2;
        const int lw = bh + 2 * ah + 4 * kh;
        for (int c = bid; c < 512; c += nb) {
            __syncthreads();
            for (int e = tid; e < 128 * 32; e += NTHR) {
                const int row = e >> 5, d4 = (e & 31) * 4;
                const float4 v = *(const float4*)(Z + (size_t)c * NT + NCTX + row * 128 + d4);
                uint2 pk; pk.x = pack2(v.x, v.y); pk.y = pack2(v.z, v.w);
                *(uint2*)&Zs[row * HZ_STR + d4] = pk;
            }
            if (tid < HZ_STR / 2) ((unsigned*)&Zs[128 * HZ_STR])[tid] = 0u;
            f32x16 acc[2][2];
#pragma unroll
            for (int i = 0; i < 2; ++i)
#pragma unroll
                for (int j = 0; j < 2; ++j)
#pragma unroll
                    for (int q = 0; q < 16; ++q) acc[i][j][q] = 0.f;
            const float* hf = HF + (size_t)c * 32768 + LSEQ;
            float w0[3], w1[3], w2[3];
#define HY_LOADW(GI) do { const int M_ = 128 * (16 * (GI) - 112); \
                _Pragma("unroll") for (int it = 0; it < 3; ++it) { const int tt_ = tid + it * NTHR; const int i0 = M_ - 2 * (tt_ - 4); \
                    w0[it] = (tt_ < 1108 && i0 > -LSEQ && i0 < LSEQ) ? hf[i0] : 0.f; \
                    w1[it] = (tt_ < 1108 && i0 - 1 > -LSEQ && i0 - 1 < LSEQ) ? hf[i0 - 1] : 0.f; \
                    w2[it] = (tt_ < 1108 && i0 - 2 > -LSEQ && i0 - 2 < LSEQ) ? hf[i0 - 2] : 0.f; } } while (0)
            HY_LOADW(0);
            for (int gi = 0; gi < 16; ++gi) {
                const int k0 = -128 + gi * 16;
                bfr* Cg = Cs + (gi & 1) * 8 * HC_LEN;
#pragma unroll
                for (int it = 0; it < 3; ++it) {
                    const int tt_ = tid + it * NTHR, t2 = 2 * (tt_ - 4);
                    if (tt_ < 1108) {
                        const unsigned pe = pack2(w0[it], w1[it]), po = pack2(w1[it], w2[it]);
#pragma unroll
                        for (int rho = 0; rho < 8; rho += 2) {
                            const int xe = t2 + rho, xo = t2 + rho + 2;
                            if (xe >= 0 && xe < HC_LEN) *(unsigned*)&Cg[rho * HC_LEN + xe] = pe;
                            if (xo >= 0 && xo < HC_LEN) *(unsigned*)&Cg[(rho + 1) * HC_LEN + xo] = po;
                        }
                    }
                }
                if (gi + 1 < 16) HY_LOADW(gi + 1);
                __syncthreads();
                const int a00 = ah * 64, a01 = ah * 64 + 32;
                const int kk_lo = max(0, a00 - 127 - k0), kk_hi = min(15, a01 + 31 - k0);
#pragma unroll 2
                for (int kk = kk_lo; kk <= kk_hi; ++kk) {
                    const int k = k0 + kk;
                    const bool act0 = (k <= a00 + 31);
                    const bool act1 = (k > a01 - 128);
                    const int row0 = a00 + r - k, row1 = a01 + r - k;
                    const int zo0 = ((unsigned)row0 < 128u ? row0 : 128) * HZ_STR + h * 8;
                    const int zo1 = ((unsigned)row1 < 128u ? row1 : 128) * HZ_STR + h * 8;
                    const int xb = (gi & 1) * 8 * HC_LEN + (r & 7) * HC_LEN + 128 * (16 - kk) - (bh * 64) - (r & ~7) + h * 8;
#pragma unroll
                    for (int dbi = 0; dbi < 4; ++dbi) {
                        const int d0 = (kh * 4 + dbi) * 16;
                        const bf16x8 af0 = *(const bf16x8*)&Cs[xb + d0];
                        const bf16x8 af1 = *(const bf16x8*)&Cs[xb + d0 - 32];
                        const bf16x8 bz0 = *(const bf16x8*)&Zs[zo0 + d0];
                        const bf16x8 bz1 = *(const bf16x8*)&Zs[zo1 + d0];
                        if (act0) {
                            acc[0][0] = __builtin_amdgcn_mfma_f32_32x32x16_bf16(af0, bz0, acc[0][0], 0, 0, 0);
                            acc[1][0] = __builtin_amdgcn_mfma_f32_32x32x16_bf16(af1, bz0, acc[1][0], 0, 0, 0);
                        }
                        if (act1) {
                            acc[0][1] = __builtin_amdgcn_mfma_f32_32x32x16_bf16(af0, bz1, acc[0][1], 0, 0, 0);
                            acc[1][1] = __builtin_amdgcn_mfma_f32_32x32x16_bf16(af1, bz1, acc[1][1], 0, 0, 0);
                        }
                    }
                }
            }
            __syncthreads();
#pragma unroll
            for (int i = 0; i < 2; ++i)
#pragma unroll
                for (int j = 0; j < 2; ++j)
#pragma unroll
                    for (int q = 0; q < 16; ++q) Red[(lw * 64 + (i * 2 + j) * 16 + q) * 64 + lane] = acc[i][j][q];
            __syncthreads();
            {
                const float part = wave_sum(((const float*)(P.ws + WS_NORMP))[(size_t)c * 520 + tid]);
                float* nred = Red + 8 * 64 * 64;
                if (lane == 0) nred[wave] = part;
                __syncthreads();
                float ntot = 0.f;
#pragma unroll
                for (int w_ = 0; w_ < 8; ++w_) ntot += nred[w_];
                const float nrm = 1.f / ntot;
                const float sk = skip[c];
                for (int t = tid; t < LSEQ; t += NTHR) {
                    const int b = t & 127, a_ = t >> 7;
                    const int bt = b >> 5, rb = b & 31, at = a_ >> 5;
                    const int hh = (rb >> 2) & 1, q = (rb & 3) + 4 * (rb >> 3);
                    const int w = (bt >> 1) + 2 * (at >> 1);
                    const int idx = (w * 64 + ((bt & 1) * 2 + (at & 1)) * 16 + q) * 64 + (a_ & 31) + 32 * hh;
                    const float v = Red[idx] + Red[idx + 4 * 64 * 64];
                    const int row = NCTX + t;
                    const float x0 = X0[(size_t)c * NT + row];
                    const float y = x0 * (v * nrm + Z[(size_t)c * NT + row] * sk);
                    ATT[(size_t)row * 1024 + 512 + c] = f2bf(y);
                }
            }
        }
#undef HY_LOADW
    }
    {
        float* zs = (float*)smraw; float* hw = zs + 512;
        for (int c = bid; c < 512; c += nb) {
            __syncthreads();
            if (tid < 256) zs[tid] = Z[(size_t)c * NT + tid];
            hw[tid] = (tid < 511) ? HFC[(size_t)c * 512 + 256 - 255 + tid] : 0.f;
            __syncthreads();
            if (tid < 256) {
                float acc = 0.f;
                const float* hp = hw + tid + 255;
                for (int j = 0; j < 256; ++j) acc += hp[-j] * zs[j];
                float nrm = 0.f;
#pragma unroll
                for (int w_ = 0; w_ < 8; ++w_) nrm += ((const float*)(P.ws + WS_NORMP))[(size_t)c * 520 + 512 + w_];
                const float x0 = short_conv(QK, cw, cb, tid, c, 0, NCTX);
                const float y = x0 * (acc / nrm + zs[tid] * skip[c]);
                ATT[(size_t)tid * 1024 + 512 + c] = f2bf(y);
            }
        }
    }
}

__device__ __forceinline__ void phase_ln_router(const Params& P, int layer, int tok0, int ntok, unsigned char* smraw, int bid, int nb, int probe = 0) {
    const bfr* PRE = (const bfr*)(P.ws + WS_PRE);
    bfr* X1 = (bfr*)(P.ws + WS_X1);
    bfr* HFF = (bfr*)(P.ws + WS_HFF);
    const float* mod = (const float*)(P.ws + WS_MOD) + (size_t)layer * 2 * 6144;
    const float* lg_ = P.in[6] + layer * 1024; const float* lb_ = P.in[7] + layer * 1024;
    const bfr* RT = (const bfr*)(P.ws + WS_ROUT) + (size_t)layer * 256 * 1024;
    const float* rbias = P.in[37] + layer * 256;
    int* COUNT = (probe ? (int*)(P.ws + 45056) : (int*)(P.ws + CTL_COUNT) + layer * NREP * CSTRIDE) + (bid & 7) * CSTRIDE;
    int* LIST = probe ? (int*)(P.ws + WS_YS) : (int*)(P.ws + WS_LIST);
    float* GATE = probe ? (float*)(P.ws + WS_YS + (size_t)64 * 1024 * 1024) : (float*)(P.ws + WS_GATE);
    bfr* hfs = (bfr*)smraw;
    float* lgt = (float*)(smraw + 32 * 1032 * 2);
    const int tid = threadIdx.x, lane = tid & 63, wave = tid >> 6;
    for (int u = bid; u < ntok / 32; u += nb) {
        const int r0 = tok0 + u * 32;
        __syncthreads();
        const int whu = r0 >= NCTX;
        float ga[16], be[16], a2[16], b2[16];
#pragma unroll
        for (int i = 0; i < 2; ++i) {
            const int c0 = i * 512 + lane * 8;
            float sc[8], sh[8];
            ld8(lg_ + c0, ga + i * 8); ld8(lb_ + c0, be + i * 8); ld8(mod + (size_t)whu * 6144 + 4096 + c0, sc); ld8(mod + (size_t)whu * 6144 + 3072 + c0, sh);
#pragma unroll
            for (int j = 0; j < 8; ++j) { a2[i * 8 + j] = ga[i * 8 + j] * (1.f + sc[j]); b2[i * 8 + j] = be[i * 8 + j] * (1.f + sc[j]) + sh[j]; }
        }
        uint4 raw[4][2];
#pragma unroll
        for (int q = 0; q < 4; ++q) {
            const bfr* src = PRE + (size_t)(r0 + wave * 4 + q) * 1024 + lane * 8;
            raw[q][0] = *(const uint4*)src; raw[q][1] = *(const uint4*)(src + 512);
        }
#pragma unroll
        for (int q = 0; q < 4; ++q) {
            const int rl = wave * 4 + q, row = r0 + rl;
            float v[16];
            up8(raw[q][0], v); up8(raw[q][1], v + 8);
            float s = 0.f;
#pragma unroll
            for (int i = 0; i < 16; ++i) s += v[i];
            const float mu = wave_sum(s) * (1.f / 1024.f);
            float s2 = 0.f;
#pragma unroll
            for (int i = 0; i < 16; ++i) { const float d = v[i] - mu; s2 += d * d; }
            const float rstd = rsqrtf(wave_sum(s2) * (1.f / 1024.f) + 1e-5f);
#pragma unroll
            for (int i = 0; i < 2; ++i) {
                const int c0 = i * 512 + lane * 8;
                float x[8], hf[8];
#pragma unroll
                for (int j = 0; j < 8; ++j) { const float n_ = (v[i * 8 + j] - mu) * rstd; x[j] = n_ * ga[i * 8 + j] + be[i * 8 + j]; hf[j] = n_ * a2[i * 8 + j] + b2[i * 8 + j]; }
                *(uint4*)(X1 + (size_t)row * 1024 + c0) = pack8(x);
                const uint4 pk = pack8(hf);
                *(uint4*)(HFF + (size_t)row * 1024 + c0) = pk;
                *(uint4*)(hfs + rl * 1032 + c0) = pk;
            }
        }
        __syncthreads();
        if (probe < 3) {
            f32x16 acc;
#pragma unroll
            for (int r = 0; r < 16; ++r) acc[r] = 0.f;
            const bfr* bp = RT + ((size_t)wave * 64 + lane) * 8;
            const bfr* ap = hfs + (lane & 31) * 1032 + (lane >> 5) * 8;
#pragma unroll 8
            for (int k = 0; k < 64; ++k) {
                const bf16x8 a = *(const bf16x8*)(ap + k * 16);
                const bf16x8 b = *(const bf16x8*)(bp + (size_t)k * 8 * 64 * 8);
                acc = __builtin_amdgcn_mfma_f32_32x32x16_bf16(a, b, acc, 0, 0, 0);
            }
#pragma unroll
            for (int r = 0; r < 16; ++r) {
                const int row = (r & 3) + 8 * (r >> 2) + 4 * (lane >> 5);
                lgt[row * 257 + wave * 32 + (lane & 31)] = acc[r];
            }
        }
        __syncthreads();
        float rb[4];
#pragma unroll
        for (int j = 0; j < 4; ++j) rb[j] = rbias[lane * 4 + j];
        int selE[4]; float selG[4];
        if (probe < 2) {
#pragma unroll
        for (int q = 0; q < 4; ++q) {
            const int rl = wave * 4 + q;
            float b[4];
#pragma unroll
            for (int j = 0; j < 4; ++j) b[j] = sigmoidf_(lgt[rl * 257 + lane * 4 + j]) + rb[j];
            float m1 = -1e30f, m2 = -1e30f;
#pragma unroll
            for (int j = 0; j < 4; ++j) { const float v = b[j]; if (v > m1) { m2 = m1; m1 = v; } else if (v > m2) m2 = v; }
#pragma unroll
            for (int off = 1; off < 8; off <<= 1) {
                const float o1 = __shfl_xor(m1, off, 64), o2 = __shfl_xor(m2, off, 64);
                const float n1 = fmaxf(m1, o1), n2 = fmaxf(fminf(m1, o1), fmaxf(m2, o2));
                m1 = n1; m2 = n2;
            }
            const float gs = m1 + m2;
            const int g = lane >> 3;
            int rank = 0;
#pragma unroll
            for (int g2 = 0; g2 < 8; ++g2) { const float v = __int_as_float(__builtin_amdgcn_readlane(__float_as_int(gs), g2 * 8)); rank += (v > gs) || (v == gs && g2 < g); }
            if (rank >= 4) {
#pragma unroll
                for (int j = 0; j < 4; ++j) b[j] = -1e30f;
            }
            int myE = 0; float myG = 0.f;
            for (int k = 0; k < 8; ++k) {
                float bv = b[0]; int bj = 0; float bb = rb[0];
#pragma unroll
                for (int j = 1; j < 4; ++j) if (b[j] > bv) { bv = b[j]; bj = j; bb = rb[j]; }
                const float wm = wave_max_dpp(bv);
                const unsigned long long bal = __ballot(bv == wm);
                const int src = __ffsll((long long)bal) - 1;
                const int e = __builtin_amdgcn_readlane(lane * 4 + bj, src);
                const float sc = __int_as_float(__builtin_amdgcn_readlane(__float_as_int(bv - bb), src));
                if (lane == k) { myE = e; myG = sc; }
                if (lane == src) {
#pragma unroll
                    for (int j = 0; j < 4; ++j) if (j == bj) b[j] = -1e30f;
                }
            }
            const float gsum = wave_sum(lane < 8 ? myG : 0.f);
            selE[q] = myE; selG[q] = 2.5f * myG / gsum;
        }
        int pos[4];
        if (lane < 8) {
#pragma unroll
            for (int q = 0; q < 4; ++q) pos[q] = atomicAdd(&COUNT[selE[q]], 1);
#pragma unroll
            for (int q = 0; q < 4; ++q) {
                const int tl = r0 + wave * 4 + q - tok0;
                LIST[((size_t)(bid & 7) * 256 + selE[q]) * LCAP + pos[q]] = tl * 9 + lane;
                GATE[(size_t)tl * 9 + lane] = selG[q];
            }
        } else if (lane == 8) {
#pragma unroll
            for (int q = 0; q < 4; ++q) GATE[(size_t)(r0 + wave * 4 + q - tok0) * 9 + 8] = 1.f;
        }
        }
    }
}

__device__ __forceinline__ void moe_prefix(const int* COUNT, int ntok, int* pre) {
    const int t = threadIdx.x, lane = t & 63, wave = t >> 6;
    __syncthreads();
    int v = 0;
    if (t < NE1) {
        int c = 0;
        if (t < 256) {
#pragma unroll
            for (int x = 0; x < NREP; ++x) { pre[1152 + t * NREP + x] = c; c += COUNT[x * CSTRIDE + t]; }
        } else c = ntok;
        v = (c + 127) >> 7; pre[272 + t] = c;
    }
    int inc = v;
#pragma unroll
    for (int o = 1; o < 64; o <<= 1) { const int u = __shfl_up(inc, o, 64); if (lane >= o) inc += u; }
    if (lane == 63) pre[260 + wave] = inc;
    __syncthreads();
    int off = 0;
    for (int w = 0; w < wave; ++w) off += pre[260 + w];
    __syncthreads();
    if (t < NE1) pre[t] = off + inc - v;
    if (t == NE1 - 1) pre[NE1] = off + inc;
    __syncthreads();
}
__device__ __forceinline__ int moe_row_pidx(const int* pre, const int* LIST, int e, int r) {
    const int* pf = pre + 1152 + e * NREP;
    int x = 0;
#pragma unroll
    for (int i = 1; i < NREP; ++i) x += (pf[i] <= r);
    return LIST[((size_t)x * 256 + e) * LCAP + (r - pf[x])];
}
__device__ __forceinline__ void moe_local(const int* pre, int* lpre, int x) {
    if (threadIdx.x == 0) {
        int s = 0;
        for (int k = 0; k < 32; ++k) { lpre[k] = s; s += pre[x + 8 * k + 1] - pre[x + 8 * k]; }
        lpre[32] = s;
        const int nsh = pre[NE1] - pre[256];
        lpre[33] = s + (nsh > x ? (nsh - x + 7) / 8 : 0);
    }
    __syncthreads();
}
__device__ __forceinline__ void moe_unit(const int* pre, const int* lpre, int x, int lb, int& e, int& rb) {
    if (lb < lpre[32]) {
        int lo = 0, hi = 32;
        while (hi - lo > 1) { const int mid = (lo + hi) >> 1; if (lpre[mid] <= lb) lo = mid; else hi = mid; }
        e = x + 8 * lo; rb = lb - lpre[lo];
    } else { e = 256; rb = (lb - lpre[32]) * 8 + x; }
}
struct EpiM1 {
    bfr* H1; int rowbase; int colbase;
    __device__ __forceinline__ bool direct() const { return false; }
    __device__ __forceinline__ void tile(const f32x16&, int, int, int, int, int) {}
    template <int BM, int BN> __device__ __forceinline__ void rows(const float* Ct, int cstr) {
        for (int id_ = threadIdx.x; id_ < BM * 16; id_ += NTHR) {
            const int r = id_ >> 4, f0 = (id_ & 15) * 8;
            const int cg = (f0 >> 5) * 64 + (f0 & 31);
            float g[8], u[8], h[8]; ld8(Ct + r * cstr + cg, g); ld8(Ct + r * cstr + cg + 32, u);
#pragma unroll
            for (int j = 0; j < 8; ++j) h[j] = siluf_(g[j]) * u[j];
            *(uint4*)&H1[((size_t)rowbase + r) * 256 + colbase + f0] = pack8(h);
        }
    }
};
__device__ __forceinline__ void phase_moe1(const Params& P, int layer, int tok0, int ntok, unsigned char* smraw, int bid, int nb) {
    const int* COUNT = (const int*)(P.ws + CTL_COUNT) + layer * NREP * CSTRIDE;
    const int* LIST = (const int*)(P.ws + WS_LIST);
    const bfr* HFF = (const bfr*)(P.ws + WS_HFF);
    bfr* H1 = (bfr*)(P.ws + WS_H1);
    bfr* smem = (bfr*)smraw;
    int* pre = (int*)(smraw + MOE_TAB_OFF);
    int* lpre = pre + 800;
    moe_prefix(COUNT, ntok, pre);
    const int xg = bid & 7, rank = bid >> 3, nrank = nb >> 3;
    moe_local(pre, lpre, xg);
    const int nunits = lpre[33] * 2;
    const int tid = threadIdx.x;
    GemmPipe<128, 256, 1024, ALoadRows, BLoadF32<256>> gp;
    ALoadRows al; BLoadF32<256> bl; bl.ldn = 256;
    EpiM1 ep, epn; ep.H1 = H1; epn.H1 = H1;
#define M1_SETUP(U, PAR, EPX) do { \
        const int nh_ = (U) & 1; int e_, rb_; moe_unit(pre, lpre, xg, (U) >> 1, e_, rb_); \
        const int blk_ = pre[e_] + rb_, cnt_ = pre[272 + e_]; \
        int* ridx_ = pre + 544 + (PAR) * 128; \
        if (tid < 128) { int r_ = rb_ * 128 + tid; if (r_ >= cnt_) r_ = cnt_ - 1; \
            const int pidx_ = (e_ < 256) ? moe_row_pidx(pre, LIST, e_, r_) : r_ * 9 + 8; ridx_[tid] = tok0 + pidx_ / 9; } \
        __syncthreads(); \
        al.init<128>(HFF, 1024, 0, NT - 1, ridx_); \
        const float* Wg_ = (e_ < 256) ? P.in[38] + ((size_t)layer * 256 + e_) * 1024 * 256 : P.in[41] + (size_t)layer * 1024 * 256; \
        const float* Wu_ = (e_ < 256) ? P.in[39] + ((size_t)layer * 256 + e_) * 1024 * 256 : P.in[42] + (size_t)layer * 1024 * 256; \
        { const int n_ = (tid & 63) * 4, wn_ = n_ >> 6, j_ = n_ & 63; \
          bl.p[0] = ((j_ < 32) ? Wg_ : Wu_) + (size_t)(tid >> 6) * 4 * 256 + nh_ * 128 + wn_ * 32 + (j_ & 31); } \
        EPX.rowbase = blk_ * 128; EPX.colbase = nh_ * 128; } while (0)
    int u = rank, par = 0;
    if (u < nunits) { M1_SETUP(u, par, ep); gp.prefetch(al, bl); }
    while (u < nunits) {
        gp.mainloop(smem, al, bl);
        const int un = u + nrank;
        if (un < nunits) { M1_SETUP(un, par ^ 1, epn); gp.prefetch(al, bl); }
        gp.epilogue(smem, ep);
        ep.rowbase = epn.rowbase; ep.colbase = epn.colbase;
        u = un; par ^= 1;
    }
#undef M1_SETUP
}
struct EpiM2 {
    bfr* YS; const int* rp; const float* GATE; int col0;
    __device__ __forceinline__ bool direct() const { return false; }
    __device__ __forceinline__ void tile(const f32x16&, int, int, int, int, int) {}
    template <int BM, int BN> __device__ __forceinline__ void rows(const float* Ct, int cstr) {
        ROWS_LOOP(BM, BN) {
            const int r = id_ / (BN / 8), c = (id_ % (BN / 8)) * 8;
            const int pidx = rp[r];
            if (pidx >= 0) {
                const float g = GATE[r];
                float v[8]; ld8(Ct + r * cstr + c, v);
#pragma unroll
                for (int j = 0; j < 8; ++j) v[j] *= g;
                *(uint4*)&YS[(size_t)pidx * 1024 + col0 + c] = pack8(v);
            }
        }
    }
};
__device__ __forceinline__ void phase_moe2(const Params& P, int layer, int tok0, int ntok, unsigned char* smraw, int bid, int nb) {
    const int* COUNT = (const int*)(P.ws + CTL_COUNT) + layer * NREP * CSTRIDE;
    const int* LIST = (const int*)(P.ws + WS_LIST);
    const bfr* H1 = (const bfr*)(P.ws + WS_H1);
    const float* GATEW = (const float*)(P.ws + WS_GATE);
    bfr* smem = (bfr*)smraw;
    int* pre = (int*)(smraw + MOE_TAB_OFF);
    int* lpre = pre + 800;
    moe_prefix(COUNT, ntok, pre);
    const int xg = bid & 7, rank = bid >> 3, nrank = nb >> 3;
    moe_local(pre, lpre, xg);
    const int nunits = lpre[33] * 4;
    const int tid = threadIdx.x;
    GemmPipe<128, 256, 256, ALoadRows, BLoadF32<256>> gp;
    ALoadRows al; BLoadF32<256> bl; bl.ldn = 1024;
    EpiM2 ep{(bfr*)(P.ws + WS_YS), nullptr, nullptr, 0}, epn{(bfr*)(P.ws + WS_YS), nullptr, nullptr, 0};
#define M2_SETUP(U, PAR, EPX) do { \
        const int nq_ = (U) & 3; int e_, rb_; moe_unit(pre, lpre, xg, (U) >> 2, e_, rb_); \
        const int blk_ = pre[e_] + rb_, cnt_ = pre[272 + e_]; \
        int* rp_ = pre + 544 + (PAR) * 128; float* rg_ = (float*)(pre + 848 + (PAR) * 128); \
        if (tid < 128) { const int r_ = rb_ * 128 + tid; \
            const int pidx_ = (r_ < cnt_) ? ((e_ < 256) ? moe_row_pidx(pre, LIST, e_, r_) : r_ * 9 + 8) : -1; \
            rp_[tid] = pidx_; rg_[tid] = (pidx_ >= 0) ? GATEW[pidx_] : 0.f; } \
        __syncthreads(); \
        al.init<128>(H1, 256, blk_ * 128, (int)H1ROWS - 1, nullptr); \
        const float* Wd_ = (e_ < 256) ? P.in[40] + ((size_t)layer * 256 + e_) * 256 * 1024 : P.in[43] + (size_t)layer * 256 * 1024; \
        bl.p[0] = Wd_ + (size_t)(tid >> 6) * 4 * 1024 + nq_ * 256 + (tid & 63) * 4; \
        EPX.rp = rp_; EPX.GATE = rg_; EPX.col0 = nq_ * 256; } while (0)
    int u = rank, par = 0;
    if (u < nunits) { M2_SETUP(u, par, ep); gp.prefetch(al, bl); }
    while (u < nunits) {
        gp.mainloop(smem, al, bl);
        const int un = u + nrank;
        if (un < nunits) { M2_SETUP(un, par ^ 1, epn); gp.prefetch(al, bl); }
        gp.epilogue(smem, ep);
        ep.rp = epn.rp; ep.GATE = epn.GATE; ep.col0 = epn.col0;
        u = un; par ^= 1;
    }
#undef M2_SETUP
}

__device__ __forceinline__ void phase_combine(const Params& P, int layer, int tok0, int ntok, int bid, int nb) {
    const bfr* YS = (const bfr*)(P.ws + WS_YS);
    const bfr* X1 = (const bfr*)(P.ws + WS_X1);
    const float* mod = (const float*)(P.ws + WS_MOD) + (size_t)layer * 2 * 6144;
    const float* modn = (const float*)(P.ws + WS_MOD) + (size_t)2 * 6144;
    const float* lg_ = P.in[8] + layer * 1024; const float* lb_ = P.in[9] + layer * 1024;
    const int lane = threadIdx.x & 63, wave = threadIdx.x >> 6;
    for (int t8 = bid; t8 < ntok / 8; t8 += nb) {
        const int tl = t8 * 8 + wave, row = tok0 + tl;
        const int wh = row >= NCTX;
        uint4 raw[9][2], xr[2];
        {
            const bfr* src = YS + (size_t)tl * 9 * 1024 + lane * 8;
#pragma unroll
            for (int k = 0; k < 9; ++k) { raw[k][0] = *(const uint4*)(src + k * 1024); raw[k][1] = *(const uint4*)(src + k * 1024 + 512); }
            xr[0] = *(const uint4*)(X1 + (size_t)row * 1024 + lane * 8); xr[1] = *(const uint4*)(X1 + (size_t)row * 1024 + 512 + lane * 8);
        }
        float y[16];
#pragma unroll
        for (int i = 0; i < 16; ++i) y[i] = 0.f;
#pragma unroll
        for (int k = 0; k < 9; ++k)
#pragma unroll
            for (int i = 0; i < 2; ++i) { float f[8]; up8(raw[k][i], f);
#pragma unroll
                for (int j = 0; j < 8; ++j) y[i * 8 + j] += f[j]; }
        const float* g2 = mod + (size_t)wh * 6144 + 5120;
        float v[16]; float s = 0.f;
#pragma unroll
        for (int i = 0; i < 2; ++i) {
            const int c0 = i * 512 + lane * 8;
            float x[8], g[8]; up8(xr[i], x); ld8(g2 + c0, g);
#pragma unroll
            for (int j = 0; j < 8; ++j) { v[i * 8 + j] = ALPHA * x[j] + g[j] * y[i * 8 + j]; s += v[i * 8 + j]; }
        }
        const float mu = wave_sum(s) * (1.f / 1024.f);
        float s2 = 0.f;
#pragma unroll
        for (int i = 0; i < 16; ++i) { const float d = v[i] - mu; s2 += d * d; }
        const float rstd = rsqrtf(wave_sum(s2) * (1.f / 1024.f) + 1e-5f);
#pragma unroll
        for (int i = 0; i < 2; ++i) {
            const int c0 = i * 512 + lane * 8;
            float x[8], ga[8], be[8]; ld8(lg_ + c0, ga); ld8(lb_ + c0, be);
#pragma unroll
            for (int j = 0; j < 8; ++j) x[j] = (v[i * 8 + j] - mu) * rstd * ga[j] + be[j];
            if (layer == 0) {
                *(uint4*)((bfr*)(P.ws + WS_X2) + (size_t)row * 1024 + c0) = pack8(x);
                float sh[8], sc[8], hh[8]; ld8(modn + (size_t)wh * 6144 + c0, sh); ld8(modn + (size_t)wh * 6144 + 1024 + c0, sc);
#pragma unroll
                for (int j = 0; j < 8; ++j) hh[j] = x[j] * (1.f + sc[j]) + sh[j];
                *(uint4*)((bfr*)(P.ws + WS_H) + (size_t)row * 1024 + c0) = pack8(hh);
            } else {
                float* o = P.out + (size_t)(row - NCTX) * 1024 + c0;
                *(float4*)o = make_float4(x[0], x[1], x[2], x[3]); *(float4*)(o + 4) = make_float4(x[4], x[5], x[6], x[7]);
            }
        }
    }
}

__device__ __forceinline__ int s5_row(int dir, int n) { return dir == 0 ? n : (n < NCTX ? NCTX - 1 - n : NT + NCTX - 1 - n); }

__device__ __forceinline__ void phase_qkprep_s5a(const Params& P, float* sm, int bid, int nb) {
    const bfr* QK = (const bfr*)(P.ws + WS_QKVU);
    bfr* QN = (bfr*)(P.ws + WS_QN); bfr* KN = (bfr*)(P.ws + WS_KN);
    const int lane = threadIdx.x & 63, wave = threadIdx.x >> 6;
    const int gw = bid * 8 + wave, nw = nb * 8;
    const float qg = P.in[24][lane], kg = P.in[25][lane];
    const int fi = (lane & 31) >> 1;
    const float invf = exp2f(-(float)fi * (13.287712379549449f / 16.f));
    for (int row = gw; row < NT; row += nw) {
        const bool lat = row >= NCTX;
        float cs = 1.f, sn = 0.f;
        if (lat) {
            const int t = row - NCTX;
            const float ang = (float)((lane < 32) ? (t >> 6) : (t & 63)) * invf;
            cs = __cosf(ang); sn = __sinf(ang);
        }
        const bfr* src = QK + (size_t)row * 1280 + lane;
#pragma unroll
        for (int slot = lat ? 0 : 8; slot < 10; ++slot) {
            const float x = bf2f(src[slot * 64]);
            const float ss = wave_sum(x * x);
            float y = x * rsqrtf(ss * (1.f / 64.f) + 1e-6f) * (slot < 8 ? qg : kg);
            if (lat) {
                const float other = __shfl_xor(y, 1, 64);
                y = (lane & 1) ? (other * sn + y * cs) : (y * cs - other * sn);
            }
            if (slot < 8) QN[(size_t)(row - NCTX) * 512 + slot * 64 + lane] = f2bf(y * (0.125f * 1.4426950408889634f));
            else KN[(size_t)row * 128 + (slot - 8) * 64 + lane] = f2bf(y);
        }
    }
    {
        bfr* VT = (bfr*)(P.ws + WS_VT);
        bfr* tile = (bfr*)sm;
        for (int u = bid; u < NT / 64; u += nb) {
            __syncthreads();
            for (int e = threadIdx.x; e < 64 * 128; e += NTHR) { const int r = e >> 7, c = e & 127; tile[c * 66 + r] = QK[(size_t)(u * 64 + r) * 1280 + 640 + c]; }
            __syncthreads();
            for (int e = threadIdx.x; e < 128 * 64; e += NTHR) { const int c = e >> 6, r = e & 63; VT[(size_t)c * NT + u * 64 + r] = tile[c * 66 + r]; }
        }
        __syncthreads();
    }
    float* us = sm + wave * 1024;
    const float2* ABAR = (const float2*)(P.ws + WS_ABAR);
    const float2* BBAR = (const float2*)(P.ws + WS_BBAR);
    float2* SE = (float2*)(P.ws + WS_SE);
    const int dg = gw & 63, dir = dg >> 5, g = dg & 31;
    const float2 a = ABAR[dg * 64 + lane];
    float br[16], bi[16];
#pragma unroll
    for (int k = 0; k < 16; ++k) { const float2 b = BBAR[((size_t)dg * 64 + lane) * 16 + k]; br[k] = b.x; bi[k] = b.y; }
    for (int unit = gw; unit < 260 * 64; unit += nw) {
        const int chunk = unit >> 6;
        lds_fence();
        {
            const int row = s5_row(dir, chunk * 64 + lane);
            const uint4* up = (const uint4*)(QK + (size_t)row * 1280 + 768 + g * 16);
            const uint4 u0 = up[0], u1 = up[1];
            float4* d = (float4*)(us + lane * 16);
            d[0] = make_float4(bflo(u0.x), bfhi(u0.x), bflo(u0.y), bfhi(u0.y));
            d[1] = make_float4(bflo(u0.z), bfhi(u0.z), bflo(u0.w), bfhi(u0.w));
            d[2] = make_float4(bflo(u1.x), bfhi(u1.x), bflo(u1.y), bfhi(u1.y));
            d[3] = make_float4(bflo(u1.z), bfhi(u1.z), bflo(u1.w), bfhi(u1.w));
        }
        lds_fence();
        float sr = 0.f, si = 0.f;
        for (int n = 0; n < 64; ++n) {
            const float4* up = (const float4*)(us + n * 16);
            float uu[16];
#pragma unroll
            for (int q = 0; q < 4; ++q) { const float4 t = up[q]; uu[q * 4] = t.x; uu[q * 4 + 1] = t.y; uu[q * 4 + 2] = t.z; uu[q * 4 + 3] = t.w; }
            float xr = 0.f, xi = 0.f;
#pragma unroll
            for (int k = 0; k < 16; ++k) { xr += br[k] * uu[k]; xi += bi[k] * uu[k]; }
            const float nr = a.x * sr - a.y * si + xr, ni = a.x * si + a.y * sr + xi;
            sr = nr; si = ni;
        }
        SE[((size_t)chunk * 64 + dg) * 64 + lane] = make_float2(sr, si);
    }
}

#define GK_STR 72
#define GV_STR 68
__device__ __forceinline__ void phase_s5b_gqa(const Params& P, unsigned char* smraw, int bid, int nb) {
    if (bid < 8) {
        const int i = bid * NTHR + threadIdx.x;
        const float2 a = ((const float2*)(P.ws + WS_A64))[i];
        const float2* SE = (const float2*)(P.ws + WS_SE);
        float2* CIN = (float2*)(P.ws + WS_CIN);
        float sr = 0.f, si = 0.f;
        for (int c0 = 0; c0 < 260; c0 += 20) {
            float2 e[20];
#pragma unroll
            for (int j = 0; j < 20; ++j) e[j] = SE[(size_t)(c0 + j) * 4096 + i];
#pragma unroll
            for (int j = 0; j < 20; ++j) {
                CIN[(size_t)(c0 + j) * 4096 + i] = make_float2(sr, si);
                const float nr = a.x * sr - a.y * si + e[j].x, ni = a.x * si + a.y * sr + e[j].y;
                sr = nr; si = ni;
            }
        }
    }
    const bfr* QN = (const bfr*)(P.ws + WS_QN); const bfr* KN = (const bfr*)(P.ws + WS_KN);
    const bfr* VT = (const bfr*)(P.ws + WS_VT);
    bfr* ATT = (bfr*)(P.ws + WS_ATT);
    bfr* Ks = (bfr*)smraw;
    bfr* Vs = Ks + 2 * 64 * GK_STR;
    const int tid = threadIdx.x, lane = tid & 63, wave = tid >> 6, r = lane & 31, h = lane >> 5;
    float gqm = fabsf(P.in[24][lane]), gkm = fabsf(P.in[25][lane]);
#pragma unroll
    for (int o = 32; o > 0; o >>= 1) { gqm = fmaxf(gqm, __shfl_xor(gqm, o, 64)); gkm = fmaxf(gkm, __shfl_xor(gkm, o, 64)); }
    const float negm0 = -(8.f * gqm * gkm * 1.4426950408889634f * 1.02f + 0.5f);
    constexpr int NTL = NT / 64;
#define GQ_QK(SACC, KB) do { \
        _Pragma("unroll") for (int kt = 0; kt < 2; ++kt) { \
            _Pragma("unroll") for (int q = 0; q < 16; ++q) SACC[kt][q] = negm0; \
            _Pragma("unroll") for (int ks = 0; ks < 4; ++ks) { \
                const bf16x8 a_ = *(const bf16x8*)&(KB)[(kt * 32 + r) * GK_STR + ks * 16 + h * 8]; \
                SACC[kt] = __builtin_amdgcn_mfma_f32_32x32x16_bf16(a_, qf[ks], SACC[kt], 0, 0, 0); } } } while (0)
    for (int u = bid; u < 256; u += nb) {
        const int qb = u >> 1, kvh = u & 1;
        const int head = kvh * 4 + (wave >> 1);
        const int tq0 = qb * 128 + (wave & 1) * 64 + r;
        bfr* Qw = Vs + 2 * 64 * GV_STR + wave * 64 * GK_STR;
        __syncthreads();
#pragma unroll
        for (int i = 0; i < 8; ++i) {
            const int row = i * 8 + (lane >> 3), ch = lane & 7;
            *(u32x4*)&Qw[row * GK_STR + ch * 8] = *(const u32x4*)(QN + (size_t)(qb * 128 + (wave & 1) * 64 + row) * 512 + head * 64 + ch * 8);
        }
        f32x16 o[2][2];
#pragma unroll
        for (int qt = 0; qt < 2; ++qt)
#pragma unroll
            for (int i = 0; i < 2; ++i)
#pragma unroll
                for (int q = 0; q < 16; ++q) o[qt][i][q] = 0.f;
        float l[2] = {0.f, 0.f};
        const int sr = tid >> 3, sc = tid & 7;
        const bfr* kp = KN + (size_t)sr * 128 + kvh * 64 + sc * 8;
        const bfr* vp = VT + (size_t)(kvh * 64 + sr) * NT + sc * 8;
        bfr* kdst = Ks + sr * GK_STR + sc * 8;
        bfr* vdst = Vs + sr * GV_STR + sc * 8;
        u32x4 rk = *(const u32x4*)kp, rv = *(const u32x4*)vp;
        __syncthreads();
        *(u32x4*)kdst = rk;
        *(u32x2*)vdst = (u32x2){rv.x, rv.y};
        *(u32x2*)(vdst + 4) = (u32x2){rv.z, rv.w};
        __syncthreads();
#pragma unroll 1
        for (int tile = 0; tile < NTL; ++tile) {
            const int cb = tile & 1;
            const bool more = tile + 1 < NTL;
            if (more) { rk = *(const u32x4*)(kp + (size_t)(tile + 1) * 64 * 128); rv = *(const u32x4*)(vp + (tile + 1) * 64); }
            const bfr* Kb = Ks + cb * 64 * GK_STR;
            const bfr* Vb = Vs + cb * 64 * GV_STR;
            f32x16 s[2][2];
#pragma unroll
            for (int qt = 0; qt < 2; ++qt)
#pragma unroll
                for (int kt = 0; kt < 2; ++kt)
#pragma unroll
                    for (int q = 0; q < 16; ++q) s[qt][kt][q] = negm0;
            __builtin_amdgcn_s_setprio(1);
#pragma unroll
            for (int ks = 0; ks < 4; ++ks) {
                const bf16x8 q0 = *(const bf16x8*)&Qw[r * GK_STR + ks * 16 + h * 8];
                const bf16x8 q1 = *(const bf16x8*)&Qw[(32 + r) * GK_STR + ks * 16 + h * 8];
#pragma unroll
                for (int kt = 0; kt < 2; ++kt) {
                    const bf16x8 a_ = *(const bf16x8*)&Kb[(kt * 32 + r) * GK_STR + ks * 16 + h * 8];
                    s[0][kt] = __builtin_amdgcn_mfma_f32_32x32x16_bf16(a_, q0, s[0][kt], 0, 0, 0);
                    s[1][kt] = __builtin_amdgcn_mfma_f32_32x32x16_bf16(a_, q1, s[1][kt], 0, 0, 0);
                }
            }
#pragma unroll
            for (int qt = 0; qt < 2; ++qt) {
                bf16x8 pf[2][2];
#pragma unroll
                for (int kt = 0; kt < 2; ++kt)
#pragma unroll
                    for (int s2 = 0; s2 < 2; ++s2) {
                        float pv[8];
#pragma unroll
                        for (int j = 0; j < 8; ++j) { pv[j] = __builtin_amdgcn_exp2f(s[qt][kt][s2 * 8 + j]); l[qt] += pv[j]; }
                        union { u32x4 u; bf16x8 v; } cv;
                        cv.u = (u32x4){pack2(pv[0], pv[1]), pack2(pv[2], pv[3]), pack2(pv[4], pv[5]), pack2(pv[6], pv[7])};
                        pf[kt][s2] = cv.v;
                    }
#pragma unroll
                for (int dt = 0; dt < 2; ++dt)
#pragma unroll
                    for (int kt = 0; kt < 2; ++kt)
#pragma unroll
                        for (int s2 = 0; s2 < 2; ++s2) {
                            const bfr* vb = &Vb[(dt * 32 + r) * GV_STR + kt * 32 + s2 * 16 + h * 4];
                            union { u32x2 u[2]; bf16x8 v; } cv;
                            cv.u[0] = *(const u32x2*)vb; cv.u[1] = *(const u32x2*)(vb + 8);
                            o[qt][dt] = __builtin_amdgcn_mfma_f32_32x32x16_bf16(cv.v, pf[kt][s2], o[qt][dt], 0, 0, 0);
                        }
            }
            __builtin_amdgcn_s_setprio(0);
            if (more) {
                *(u32x4*)(kdst + (cb ^ 1) * 64 * GK_STR) = rk;
                *(u32x2*)(vdst + (cb ^ 1) * 64 * GV_STR) = (u32x2){rv.x, rv.y};
                *(u32x2*)(vdst + (cb ^ 1) * 64 * GV_STR + 4) = (u32x2){rv.z, rv.w};
            }
            __syncthreads();
        }
#pragma unroll
        for (int qt = 0; qt < 2; ++qt) {
            const float lt = l[qt] + __shfl_xor(l[qt], 32, 64);
            const float inv = 1.f / lt;
            bfr* op = ATT + (size_t)(NCTX + tq0 + qt * 32) * 1024 + head * 64;
#pragma unroll
            for (int dt = 0; dt < 2; ++dt)
#pragma unroll
                for (int g4 = 0; g4 < 4; ++g4) {
                    uint2 pk;
                    pk.x = pack2(o[qt][dt][g4 * 4 + 0] * inv, o[qt][dt][g4 * 4 + 1] * inv);
                    pk.y = pack2(o[qt][dt][g4 * 4 + 2] * inv, o[qt][dt][g4 * 4 + 3] * inv);
                    *(uint2*)(op + dt * 32 + g4 * 8 + h * 4) = pk;
                }
        }
    }
#undef GQ_QK
}

#define SSTR 136
__device__ __forceinline__ void phase_s5c(const Params& P, unsigned char* smraw, int bid, int nb) {
    const bfr* QK = (const bfr*)(P.ws + WS_QKVU);
    const float2* ABAR = (const float2*)(P.ws + WS_ABAR);
    const float2* BBAR = (const float2*)(P.ws + WS_BBAR);
    const float2* CIN = (const float2*)(P.ws + WS_CIN);
    const bfr* CMAT = (const bfr*)(P.ws + WS_CMAT);
    const float* dsk = P.in[33];
    bfr* Y5 = (bfr*)(P.ws + WS_Y5);
    const int lane = threadIdx.x & 63, wave = threadIdx.x >> 6;
    float* us = (float*)(smraw + wave * (4096 + 32 * SSTR * 2));
    bfr* S = (bfr*)((unsigned char*)us + 4096);
    const int gw = bid * 8 + wave, nw = nb * 8;
    const int g = gw & 31;
    constexpr int MAXU = 4;
    f32x4 acc[MAXU][4];
#pragma unroll
    for (int ui = 0; ui < MAXU; ++ui)
#pragma unroll
        for (int i = 0; i < 4; ++i) acc[ui][i] = (f32x4){0.f, 0.f, 0.f, 0.f};
    for (int ubase = gw; ubase < 256 * 32; ubase += MAXU * nw) {
#pragma unroll
        for (int dir = 0; dir < 2; ++dir) {
            const int dg = dir * 32 + g;
            const float2 a = ABAR[dg * 64 + lane];
            float br[16], bi[16];
#pragma unroll
            for (int k = 0; k < 16; ++k) { const float2 b = BBAR[((size_t)dg * 64 + lane) * 16 + k]; br[k] = b.x; bi[k] = b.y; }
            bf16x8 cf[4];
#pragma unroll
            for (int ks = 0; ks < 4; ++ks) cf[ks] = *(const bf16x8*)(CMAT + ((size_t)dg * 16 + (lane & 15)) * 128 + ks * 32 + (lane >> 4) * 8);
#pragma unroll
            for (int ui = 0; ui < MAXU; ++ui) {
                const int unit = ubase + ui * nw;
                if (unit < 256 * 32) {
                    const int cq = unit >> 5;
                    const int chunk = dir == 0 ? 4 + cq : 259 - cq;
                    lds_fence();
                    {
                        const int row = s5_row(dir, chunk * 64 + lane);
                        const uint4* up = (const uint4*)(QK + (size_t)row * 1280 + 768 + g * 16);
                        const uint4 u0 = up[0], u1 = up[1];
                        float4* d = (float4*)(us + lane * 16);
                        d[0] = make_float4(bflo(u0.x), bfhi(u0.x), bflo(u0.y), bfhi(u0.y));
                        d[1] = make_float4(bflo(u0.z), bfhi(u0.z), bflo(u0.w), bfhi(u0.w));
                        d[2] = make_float4(bflo(u1.x), bfhi(u1.x), bflo(u1.y), bfhi(u1.y));
                        d[3] = make_float4(bflo(u1.z), bfhi(u1.z), bflo(u1.w), bfhi(u1.w));
                    }
                    lds_fence();
                    const float2 cin = CIN[((size_t)chunk * 64 + dg) * 64 + lane];
                    float sr = cin.x, si = cin.y;
#pragma unroll
                    for (int hs = 0; hs < 2; ++hs) {
                        for (int n = hs * 32; n < hs * 32 + 32; ++n) {
                            const float4* up = (const float4*)(us + n * 16);
                            float uu[16];
#pragma unroll
                            for (int q = 0; q < 4; ++q) { const float4 t = up[q]; uu[q * 4] = t.x; uu[q * 4 + 1] = t.y; uu[q * 4 + 2] = t.z; uu[q * 4 + 3] = t.w; }
                            float xr = 0.f, xi = 0.f;
#pragma unroll
                            for (int k = 0; k < 16; ++k) { xr += br[k] * uu[k]; xi += bi[k] * uu[k]; }
                            const float nr = a.x * sr - a.y * si + xr, ni = a.x * si + a.y * sr + xi;
                            sr = nr; si = ni;
                            const int tl = dir == 0 ? n : 63 - n;
                            *(unsigned*)(S + (tl & 31) * SSTR + 2 * lane) = pack2(sr, si);
                        }
                        lds_fence();
                        const int th = dir == 0 ? hs : 1 - hs;
#pragma unroll
                        for (int mt = 0; mt < 2; ++mt)
#pragma unroll
                            for (int ks = 0; ks < 4; ++ks) {
                                const bf16x8 af = *(const bf16x8*)(S + (mt * 16 + (lane & 15)) * SSTR + ks * 32 + (lane >> 4) * 8);
                                acc[ui][th * 2 + mt] = __builtin_amdgcn_mfma_f32_16x16x32_bf16(af, cf[ks], acc[ui][th * 2 + mt], 0, 0, 0);
                            }
                        lds_fence();
                    }
                }
            }
        }
        const int ch = g * 16 + (lane & 15);
        const float dk = dsk[ch];
#pragma unroll
        for (int ui = 0; ui < MAXU; ++ui) {
            const int unit = ubase + ui * nw;
            if (unit < 256 * 32) {
                const int t0 = (unit >> 5) * 64;
#pragma unroll
                for (int mt = 0; mt < 4; ++mt)
#pragma unroll
                    for (int r = 0; r < 4; ++r) {
                        const int t = t0 + mt * 16 + (lane >> 4) * 4 + r;
                        const float u = bf2f(QK[(size_t)(NCTX + t) * 1280 + 768 + ch]);
                        Y5[(size_t)t * 512 + ch] = f2bf(gelu_tanh(acc[ui][mt][r] + dk * u));
                        acc[ui][mt][r] = 0.f;
                    }
            }
        }
    }
}

struct EpiGlu {
    const bfr* Y5; const float* gb; bfr* ATT; int row0, col0;
    __device__ __forceinline__ bool direct() const { return false; }
    __device__ __forceinline__ void tile(const f32x16&, int, int, int, int, int) {}
    template <int BM, int BN> __device__ __forceinline__ void rows(const float* Ct, int cstr) {
        ROWS_LOOP(BM, BN) {
            const int r = id_ / (BN / 8), c = (id_ % (BN / 8)) * 8;
            const int t = row0 + r, col = col0 + c;
            float v[8], b[8]; ld8(Ct + r * cstr + c, v); ld8(gb + col, b);
            const uint4 yy = *(const uint4*)&Y5[(size_t)t * 512 + col];
            const float y[8] = {bflo(yy.x), bfhi(yy.x), bflo(yy.y), bfhi(yy.y), bflo(yy.z), bfhi(yy.z), bflo(yy.w), bfhi(yy.w)};
#pragma unroll
            for (int j = 0; j < 8; ++j) v[j] = y[j] * sigmoidf_(v[j] + b[j]);
            *(uint4*)&ATT[(size_t)(NCTX + t) * 1024 + 512 + col] = pack8(v);
        }
    }
};
__device__ __forceinline__ void phase_glu(const Params& P, bfr* smem, int bid, int nb) {
    const bfr* Y5 = (const bfr*)(P.ws + WS_Y5);
    const bfr* Bt = (const bfr*)(P.ws + WS_GLUT);
    constexpr int nu = 64 * 4;
    GemmPipe<256, 128, 512, ALoadRows, BLoadT> gp;
    ALoadRows al; BLoadT bl;
    int u = bid;
    if (u < nu) { al.init<256>(Y5, 512, (u >> 2) * 256, LSEQ - 1, nullptr); bl.init<128>(Bt, 512, (u & 3) * 128); gp.prefetch(al, bl); }
    while (u < nu) {
        EpiGlu ep{Y5, P.in[35], (bfr*)(P.ws + WS_ATT), (u >> 2) * 256, (u & 3) * 128};
        gp.mainloop(smem, al, bl);
        const int un = u + nb;
        if (un < nu) { al.init<256>(Y5, 512, (un >> 2) * 256, LSEQ - 1, nullptr); bl.init<128>(Bt, 512, (un & 3) * 128); gp.prefetch(al, bl); }
        gp.epilogue(smem, ep);
        u = un;
    }
}

__global__ void __launch_bounds__(NTHR, 2) fwd_kernel(Params P) {
    extern __shared__ __attribute__((aligned(16))) unsigned char lds[];
    const int bid = blockIdx.x, nb = gridDim.x;
    unsigned char* sm = lds + 16;
#if MK_SINGLE
    if (threadIdx.x == 0) { ((volatile unsigned*)lds)[0] = 0u; ((volatile unsigned*)lds)[1] = 0u; ((volatile unsigned*)lds)[2] = 0u; ((volatile unsigned*)lds)[3] = 0u; }
    __syncthreads();
    XcdBarrier bar = xcd_barrier_post((unsigned*)P.ws, (volatile LAS unsigned*)lds);
#define SEAM(k) do { if (P.lo <= (k) && (k) + 1 < P.hi) xcd_barrier(bar); } while (0)
#else
#define SEAM(k) do { } while (0)
#endif
#define IN(k) (P.lo <= (k) && (k) < P.hi)
    bfr* gsm = (bfr*)sm;
    if (IN(0)) { phase_prologue(P, (float*)sm, bid, nb); SEAM(0); }
    if (IN(1)) { if (PROBE_DUP == 102) { for (int rr_ = 0; rr_ < 4; ++rr_) phase_h0(P, bid, nb); } phase_h0(P, bid, nb); if (PROBE_DUP == 1) { phase_h0(P, bid, nb); } SEAM(1); }
    if (IN(2)) { phase_inproj0(P, gsm, bid, nb); if (PROBE_DUP == 2) { phase_inproj0(P, gsm, bid, nb); } SEAM(2); }
    if (IN(3)) { phase_na_attention(P, (float*)sm, bid, nb); phase_zprep(P, (float*)sm, bid, nb); if (PROBE_DUP == 3) { phase_na_attention(P, (float*)sm, bid, nb); } if (PROBE_DUP == 30) { phase_zprep(P, (float*)sm, bid, nb); } if (PROBE_DUP == 99) { for (int i_ = 0; i_ < 10; ++i_) xcd_barrier(bar); } SEAM(3); }
    if (IN(4)) { phase_longconv(P, sm, bid, nb); if (PROBE_DUP == 4) { phase_longconv(P, sm, bid, nb); } SEAM(4); }
    if (IN(5)) { phase_outproj(P, 0, gsm, bid, nb); if (PROBE_DUP == 5) { phase_outproj(P, 0, gsm, bid, nb); } SEAM(5); }
    if (IN(6)) { if (PROBE_DUP >= 60 && PROBE_DUP < 64) { phase_ln_router(P, 0, 0, NT, sm, bid, nb, PROBE_DUP - 59); } phase_ln_router(P, 0, 0, NT, sm, bid, nb); SEAM(6); }
    if (IN(7)) { phase_moe1(P, 0, 0, NT, sm, bid, nb); if (PROBE_DUP == 7) { phase_moe1(P, 0, 0, NT, sm, bid, nb); } SEAM(7); }
    if (IN(8)) { phase_moe2(P, 0, 0, NT, sm, bid, nb); if (PROBE_DUP == 8) { phase_moe2(P, 0, 0, NT, sm, bid, nb); } SEAM(8); }
    if (IN(9)) { phase_combine(P, 0, 0, NT, bid, nb); if (PROBE_DUP == 9) { phase_combine(P, 0, 0, NT, bid, nb); } SEAM(9); }
    if (IN(10)) { phase_gemm_bf16out((const bfr*)(P.ws + WS_H), 1024, 0, NT, (const bfr*)(P.ws + WS_WINT1), 1280, 1024, (bfr*)(P.ws + WS_QKVU), 1280, gsm, bid, nb); if (PROBE_DUP == 10) { phase_gemm_bf16out((const bfr*)(P.ws + WS_H), 1024, 0, NT, (const bfr*)(P.ws + WS_WINT1), 1280, 1024, (bfr*)(P.ws + WS_QKVU), 1280, gsm, bid, nb); } SEAM(10); }
    if (IN(11)) { phase_qkprep_s5a(P, (float*)sm, bid, nb); if (PROBE_DUP == 11) { phase_qkprep_s5a(P, (float*)sm, bid, nb); } SEAM(11); }
    if (IN(12)) { phase_s5b_gqa(P, sm, bid, nb); if (PROBE_DUP == 12) { phase_s5b_gqa(P, sm, bid, nb); } SEAM(12); }
    if (IN(13)) { phase_s5c(P, sm, bid, nb); if (PROBE_DUP == 13) { phase_s5c(P, sm, bid, nb); } SEAM(13); }
    if (IN(14)) { phase_glu(P, gsm, bid, nb); if (PROBE_DUP == 14) { phase_glu(P, gsm, bid, nb); } SEAM(14); }
    if (IN(15)) { phase_outproj(P, 1, gsm, bid, nb); SEAM(15); }
    if (IN(16)) { phase_ln_router(P, 1, NCTX, LSEQ, sm, bid, nb); SEAM(16); }
    if (IN(17)) { phase_moe1(P, 1, NCTX, LSEQ, sm, bid, nb); SEAM(17); }
    if (IN(18)) { phase_moe2(P, 1, NCTX, LSEQ, sm, bid, nb); SEAM(18); }
    if (IN(19)) { phase_combine(P, 1, NCTX, LSEQ, bid, nb); }
}

extern "C" void kernel_launch(void* const* d_in, const int* in_sizes, int n_in, void* d_out, int out_size, void* d_ws, size_t ws_size, hipStream_t stream) {
    static int grid = 0;
    if (grid == 0) {
        if (n_in != 44 || ws_size < WS_END) { fprintf(stderr, "kernel_launch: need 44 inputs and %zu bytes of workspace (got %d, %zu)\n", (size_t)WS_END, n_in, ws_size); grid = -1; return; }
        int dev = 0, cus = 0, per_cu = 0;
        hipGetDevice(&dev);
        hipDeviceGetAttribute(&cus, hipDeviceAttributeMultiprocessorCount, dev);
        if (hipFuncSetAttribute((const void*)fwd_kernel, hipFuncAttributeMaxDynamicSharedMemorySize, LDS_BYTES) != hipSuccess) { fprintf(stderr, "kernel_launch: hipFuncSetAttribute failed\n"); grid = -1; return; }
        if (hipOccupancyMaxActiveBlocksPerMultiprocessor(&per_cu, (const void*)fwd_kernel, NTHR, LDS_BYTES) != hipSuccess || per_cu < 1) { fprintf(stderr, "kernel_launch: occupancy query says %d\n", per_cu); (void)hipGetLastError(); }
        grid = (cus / 8) * 8;
    }
    if (grid < 0) return;
    hipMemsetAsync(d_ws, 0, CTL_BYTES, stream);
    Params p{};
    for (int i = 0; i < 44; ++i) p.in[i] = (const float*)d_in[i];
    p.out = (float*)d_out; p.ws = (unsigned char*)d_ws;
#if MK_SINGLE
    p.lo = 0; p.hi = NPH;
    hipLaunchKernelGGL(fwd_kernel, dim3(grid), dim3(NTHR), LDS_BYTES, stream, p);
#else
    for (int ph = 0; ph < NPH; ++ph) {
        p.lo = ph; p.hi = ph + 1;
        hipLaunchKernelGGL(fwd_kernel, dim3(grid), dim3(NTHR), LDS_BYTES, stream, p);
    }
#endif
}
```

```cpp
#include <hip/hip_runtime.h>
#include <stdint.h>
#include <stdio.h>

#ifndef MK_SINGLE
#define MK_SINGLE 1
#endif

#define DM 1024
#define LSEQ 16384
#define NCTX 256
#define NT 16640
#define NEXP 256
#define NE1 257
#define ALPHA 1.41421356237f
#define NPH 20
#ifndef PROBE_DUP
#define PROBE_DUP -1
#endif
#define NTHR 512

typedef unsigned short bfr;
typedef __attribute__((ext_vector_type(8))) short bf16x8;
typedef __attribute__((ext_vector_type(16))) float f32x16;
typedef __attribute__((ext_vector_type(4))) float f32x4;
typedef __attribute__((ext_vector_type(4))) unsigned u32x4;
typedef __attribute__((ext_vector_type(2))) unsigned u32x2;

constexpr size_t al256(size_t x) { return (x + 255) & ~size_t(255); }
constexpr size_t CTL_BYTES = 65536;
constexpr size_t CTL_COUNT = 24576;
#define NREP 8
#define CSTRIDE 264
#define LCAP 2080
constexpr size_t CTL_NORM  = 20480;
constexpr size_t CTL_NORMC = 22528;
constexpr size_t WS_MOD    = CTL_BYTES;
constexpr size_t WS_WINT0  = al256(WS_MOD + 2 * 2 * 6144 * 4);
constexpr size_t WS_WOUTT0 = al256(WS_WINT0 + (size_t)3072 * 1024 * 2);
constexpr size_t WS_WINT1  = al256(WS_WOUTT0 + (size_t)1024 * 1024 * 2);
constexpr size_t WS_WOUTT1 = al256(WS_WINT1 + (size_t)1280 * 1024 * 2);
constexpr size_t WS_ROUT   = al256(WS_WOUTT1 + (size_t)1024 * 1024 * 2);
constexpr size_t WS_GLUT   = al256(WS_ROUT + (size_t)2 * 256 * 1024 * 2);
constexpr size_t WS_HF     = al256(WS_GLUT + (size_t)512 * 512 * 2);
constexpr size_t WS_HFC    = al256(WS_HF + (size_t)512 * 32768 * 4);
constexpr size_t WS_ABAR   = al256(WS_HFC + (size_t)512 * 512 * 4);
constexpr size_t WS_A64    = al256(WS_ABAR + 4096 * 8);
constexpr size_t WS_BBAR   = al256(WS_A64 + 4096 * 8);
constexpr size_t WS_CMAT   = al256(WS_BBAR + (size_t)4096 * 16 * 8);
constexpr size_t WS_H      = al256(WS_CMAT + (size_t)64 * 16 * 128 * 2);
constexpr size_t WS_QKVU   = al256(WS_H + (size_t)NT * 1024 * 2);
constexpr size_t WS_Z      = al256(WS_QKVU + (size_t)NT * 3072 * 2);
constexpr size_t WS_ATT    = al256(WS_Z + (size_t)512 * NT * 4);
constexpr size_t WS_PRE    = al256(WS_ATT + (size_t)NT * 1024 * 2);
constexpr size_t WS_X1     = al256(WS_PRE + (size_t)NT * 1024 * 4);
constexpr size_t WS_HFF    = al256(WS_X1 + (size_t)NT * 1024 * 4);
constexpr size_t WS_X2     = al256(WS_HFF + (size_t)NT * 1024 * 2);
constexpr size_t WS_LIST   = al256(WS_X2 + (size_t)NT * 1024 * 4);
constexpr size_t WS_GATE   = al256(WS_LIST + (size_t)256 * NT * 4);
constexpr size_t H1ROWS    = (size_t)NT * 9 + 257 * 192;
constexpr size_t WS_H1     = al256(WS_GATE + (size_t)NT * 9 * 4);
constexpr size_t WS_YS     = al256(WS_H1 + H1ROWS * 256 * 2);
constexpr size_t WS_QN     = al256(WS_YS + (size_t)NT * 9 * 1024 * 2);
constexpr size_t WS_KN     = al256(WS_QN + (size_t)LSEQ * 512 * 2);
constexpr size_t WS_SE     = al256(WS_KN + (size_t)NT * 128 * 2);
constexpr size_t WS_CIN    = al256(WS_SE + (size_t)260 * 4096 * 8);
constexpr size_t WS_Y5     = al256(WS_CIN + (size_t)260 * 4096 * 8);
constexpr size_t WS_VT     = al256(WS_Y5 + (size_t)LSEQ * 512 * 2);
constexpr size_t WS_VT0    = al256(WS_VT + (size_t)128 * NT * 2);
constexpr size_t WS_X0     = al256(WS_VT0 + (size_t)512 * NT * 2);
constexpr size_t WS_K0F    = al256(WS_X0 + (size_t)512 * NT * 4);
constexpr size_t WS_NORMP  = al256(WS_K0F + (size_t)512 * NT * 2);
constexpr size_t WS_S5E    = al256(WS_NORMP + (size_t)520 * 512 * 4);
constexpr size_t WS_S5F    = al256(WS_S5E + (size_t)64 * 4 * 64 * 512 * 2);
constexpr size_t WS_S5G    = al256(WS_S5F + (size_t)64 * 64 * 512 * 2);
constexpr size_t WS_END    = al256(WS_S5G + (size_t)64 * 32 * 8 * 512 * 2);

constexpr int LDS_BYTES = 147456;

struct Params {
    const float* in[44];
    float* out;
    unsigned char* ws;
    int lo, hi;
};

#define XB_TMO      128
#define XB_XCNT(j)  (256  + 64 * (j))
#define XB_XSUB(j)  (1280 + 64 * (j))
#define XB_XGEN(j)  (2304 + 64 * (j))
#define XB_TOP      3328
#define XB_TOPGEN   3392
#define XCD_BAR_WORDS 3456
#define XB_SPIN_CAP (1u << 21)
#define LAS __attribute__((address_space(3)))

__device__ __forceinline__ unsigned xb_ld(unsigned* p)              { return __hip_atomic_load(p, __ATOMIC_RELAXED, __HIP_MEMORY_SCOPE_AGENT); }
__device__ __forceinline__ unsigned xb_add(unsigned* p, unsigned v) { return __hip_atomic_fetch_add(p, v, __ATOMIC_RELAXED, __HIP_MEMORY_SCOPE_AGENT); }
__device__ __forceinline__ unsigned xb_xcc_id() { return (unsigned)__builtin_amdgcn_s_getreg((3 << 11) | 20) & 0xFu; }
#define XB_SPIN(cond, bar) do { unsigned _sp = 0; while (cond) { __builtin_amdgcn_s_sleep(1); \
    if ((++_sp & 255u) == 0u) { if (xb_ld(&(bar)[XB_TMO])) break; if (_sp > XB_SPIN_CAP) { atomicAdd(&(bar)[XB_TMO], 1u); break; } } } } while (0)

struct XcdBarrier { unsigned* bar; unsigned x; volatile LAS unsigned* st; };

__device__ __forceinline__ XcdBarrier xcd_barrier_post(unsigned* bar, volatile LAS unsigned* st) {
    XcdBarrier b; b.bar = bar; b.x = xb_xcc_id(); b.st = st;
    if (threadIdx.x == 0) (void)xb_add(&bar[XB_XCNT(b.x)], 1u);
    return b;
}
__device__ __forceinline__ void xcd_barrier_complete(unsigned* bar, unsigned x, unsigned& nloc, unsigned& nx) {
    const unsigned G = gridDim.x * gridDim.y * gridDim.z;
    unsigned sum, cnt, mine, sp = 0u;
    for (;;) {
        sum = 0u; cnt = 0u; mine = 0u;
#pragma unroll
        for (unsigned j = 0; j < 16; ++j) { const unsigned c = xb_ld(&bar[XB_XCNT(j)]); sum += c; cnt += (c > 0u) ? 1u : 0u; mine = (j == x) ? c : mine; }
        if (sum == G) break;
        __builtin_amdgcn_s_sleep(1);
        if ((++sp & 255u) == 0u) { if (xb_ld(&bar[XB_TMO])) break; if (sp > XB_SPIN_CAP) { atomicAdd(&bar[XB_TMO], 1u); break; } }
    }
    nloc = mine > 0u ? mine : 1u; nx = cnt > 0u ? cnt : 1u;
}
__device__ __forceinline__ void xcd_barrier(const XcdBarrier& b) {
    asm volatile("s_waitcnt vmcnt(0)" ::: "memory");
    __syncthreads();
    if (threadIdx.x == 0) {
        unsigned* bar = b.bar;
        __builtin_amdgcn_s_waitcnt(0);
        unsigned nloc = b.st[0], nx = b.st[1];
        if (nloc == 0u) { xcd_barrier_complete(bar, b.x, nloc, nx); b.st[0] = nloc; b.st[1] = nx; }
        const unsigned old = xb_add(&bar[XB_XSUB(b.x)], 1u);
        const unsigned gen = old / nloc;
        if (old + 1u == (gen + 1u) * nloc) {
            __builtin_amdgcn_fence(__ATOMIC_RELEASE, "agent");
            asm volatile("s_waitcnt vmcnt(0)" ::: "memory");
            const unsigned og = xb_add(&bar[XB_TOP], 1u);
            const unsigned tg = og / nx;
            if (og + 1u == (tg + 1u) * nx) xb_add(&bar[XB_TOPGEN], 1u);
            else XB_SPIN(xb_ld(&bar[XB_TOPGEN]) == tg, bar);
            __builtin_amdgcn_fence(__ATOMIC_ACQUIRE, "agent");
            xb_add(&bar[XB_XGEN(b.x)], 1u);
            asm volatile("s_waitcnt vmcnt(0)" ::: "memory");
        } else {
            XB_SPIN(xb_ld(&bar[XB_XGEN(b.x)]) == gen, bar);
            __builtin_amdgcn_fence(__ATOMIC_ACQUIRE, "agent");
            asm volatile("s_waitcnt vmcnt(0)" ::: "memory");
        }
    }
    __syncthreads();
}

typedef __bf16 hbf16x2_t __attribute__((ext_vector_type(2)));
typedef float hf32x2_t __attribute__((ext_vector_type(2)));
__device__ __forceinline__ unsigned pack2(float a, float b) {
    hf32x2_t f = {a, b};
    return __builtin_bit_cast(unsigned, __builtin_convertvector(f, hbf16x2_t));
}
__device__ __forceinline__ bfr f2bf(float f) { return (bfr)(pack2(f, 0.f) & 0xffffu); }
__device__ __forceinline__ float bf2f(bfr h) { return __uint_as_float(((unsigned)h) << 16); }
__device__ __forceinline__ float bflo(unsigned u) { return __uint_as_float(u << 16); }
__device__ __forceinline__ float bfhi(unsigned u) { return __uint_as_float(u & 0xffff0000u); }
__device__ __forceinline__ unsigned char f2fp8(float f) { return (unsigned char)(__builtin_amdgcn_cvt_pk_fp8_f32(f, f, 0, false) & 0xff); }
__device__ __forceinline__ float sigmoidf_(float x) { return __builtin_amdgcn_rcpf(1.f + __expf(-x)); }
__device__ __forceinline__ float siluf_(float x) { return x * __builtin_amdgcn_rcpf(1.f + __expf(-x)); }
__device__ __forceinline__ float gelu_tanh(float x) {
    const float u2 = 1.5957691216057308f * (x + 0.044715f * x * x * x);
    return x * __builtin_amdgcn_rcpf(1.f + __expf(-u2));
}
__device__ __forceinline__ float wave_sum(float v) {
#define DPPADD(ctrl, rmask) v += __int_as_float(__builtin_amdgcn_update_dpp(0, __float_as_int(v), ctrl, rmask, 0xf, true))
    DPPADD(0x111, 0xf); DPPADD(0x112, 0xf); DPPADD(0x114, 0xf); DPPADD(0x118, 0xf);
    DPPADD(0x142, 0xa); DPPADD(0x143, 0xc);
#undef DPPADD
    return __int_as_float(__builtin_amdgcn_readlane(__float_as_int(v), 63));
}
__device__ __forceinline__ float wave_max_dpp(float v) {
#define DPPMAX(ctrl, rmask) v = fmaxf(v, __int_as_float(__builtin_amdgcn_update_dpp(__float_as_int(v), __float_as_int(v), ctrl, rmask, 0xf, false)))
    DPPMAX(0x111, 0xf); DPPMAX(0x112, 0xf); DPPMAX(0x114, 0xf); DPPMAX(0x118, 0xf);
    DPPMAX(0x142, 0xa); DPPMAX(0x143, 0xc);
#undef DPPMAX
    return __int_as_float(__builtin_amdgcn_readlane(__float_as_int(v), 63));
}
__device__ __forceinline__ void lds_fence() { asm volatile("s_waitcnt lgkmcnt(0)" ::: "memory"); }

#define LSTR 40

struct RawB16 { u32x4 v; __device__ __forceinline__ void st(bfr* base, int id) const { *(u32x4*)&base[(id >> 2) * LSTR + (id & 3) * 8] = v; } };
struct RawF32 { float v[8]; __device__ __forceinline__ uint4 pack() const { uint4 r; r.x = pack2(v[0], v[1]); r.y = pack2(v[2], v[3]); r.z = pack2(v[4], v[5]); r.w = pack2(v[6], v[7]); return r; } };
struct ALoadRows {
    typedef RawB16 Raw;
    const bfr* p[2];
    template <int BM> __device__ __forceinline__ void init(const bfr* base, int ld, int row0, int maxrow, const int* ridx) {
#pragma unroll
        for (int i = 0; i < (BM * 4 + NTHR - 1) / NTHR; ++i) {
            const int id = threadIdx.x + i * NTHR, kc = id & 3;
            int r = id >> 2; if (r > BM - 1) r = BM - 1;
            int row = ridx ? ridx[r] : row0 + r;
            if (row > maxrow) row = maxrow;
            p[i] = base + (size_t)row * ld + kc * 8;
        }
    }
    __device__ __forceinline__ static void map(int id, int& r, int& kc) { r = id >> 2; kc = id & 3; }
    __device__ __forceinline__ void load(int i, int k0, Raw& r) const { r.v = *(const u32x4*)(p[i] + k0); }
};
struct BLoadT {
    typedef RawB16 Raw;
    static constexpr int DEPTH = 3;
    __device__ __forceinline__ static bf16x8 frag(const bfr* Bb, int wn, int ni, int ks, int lane) {
        return *(const bf16x8*)&Bb[(wn * 64 + ni * 32 + (lane & 31)) * LSTR + ks * 16 + (lane >> 5) * 8];
    }
    template <int BN> static constexpr int chunks() { return BN * 4 / NTHR; }
    const bfr* p[2];
    template <int BN> __device__ __forceinline__ void init(const bfr* base, int ld, int n0) {
#pragma unroll
        for (int i = 0; i < BN * 4 / NTHR; ++i) {
            const int id = threadIdx.x + i * NTHR, r = id >> 2, kc = id & 3;
            p[i] = base + (size_t)(n0 + r) * ld + kc * 8;
        }
    }
    __device__ __forceinline__ static void map(int id, int& r, int& kc) { r = id >> 2; kc = id & 3; }
    __device__ __forceinline__ void load(int i, int k0, Raw& r) const { r.v = *(const u32x4*)(p[i] + k0); }
};
#define KSTR 288
typedef short v4s16 __attribute__((ext_vector_type(4)));
typedef int v8i_t __attribute__((ext_vector_type(8)));
struct RawF32Q {
    f32x4 v0, v1, v2, v3;
    __device__ __forceinline__ void st(bfr* base, int id) const {
        bfr* d = base + ((id >> 6) * 4) * KSTR + (id & 63) * 4;
        *(u32x2*)(d)            = (u32x2){pack2(v0.x, v0.y), pack2(v0.z, v0.w)};
        *(u32x2*)(d + KSTR)     = (u32x2){pack2(v1.x, v1.y), pack2(v1.z, v1.w)};
        *(u32x2*)(d + 2 * KSTR) = (u32x2){pack2(v2.x, v2.y), pack2(v2.z, v2.w)};
        *(u32x2*)(d + 3 * KSTR) = (u32x2){pack2(v3.x, v3.y), pack2(v3.z, v3.w)};
    }
};
template <int BN> struct BLoadF32 {
    typedef RawF32Q Raw;
    static constexpr int DEPTH = 2;
    __device__ __forceinline__ static bf16x8 frag(const bfr* Bb, int wn, int ni, int ks, int lane) {
        const int g = lane >> 4, q = (lane & 15) >> 2, pp = lane & 3;
        const bfr* a = Bb + (ks * 16 + 8 * (g >> 1) + q) * KSTR + wn * 64 + ni * 32 + 16 * (g & 1) + 4 * pp;
        union { v4s16 h[2]; bf16x8 v; } cv;
        cv.h[0] = __builtin_amdgcn_ds_read_tr16_b64_v4i16((v4s16 LAS*)a);
        cv.h[1] = __builtin_amdgcn_ds_read_tr16_b64_v4i16((v4s16 LAS*)(a + 4 * KSTR));
        return cv.v;
    }
    template <int BN_> static constexpr int chunks() { return BN_ * 32 / 16 / NTHR; }
    const float* p[2]; int ldn;
    __device__ __forceinline__ void load(int i, int k0, Raw& r) const {
        const float* q = p[i] + (size_t)k0 * ldn;
        r.v0 = *(const f32x4*)(q); r.v1 = *(const f32x4*)(q + (size_t)ldn); r.v2 = *(const f32x4*)(q + (size_t)2 * ldn); r.v3 = *(const f32x4*)(q + (size_t)3 * ldn);
    }
};

#define GD 3
template <class L, int N, int PART = 0> struct GSlot {
    typename L::Raw r0, r1;
    __device__ __forceinline__ void load(const L& l, int k0) { l.load(0, k0, r0); if constexpr (N > 1) { if (PART == 0 || (int)threadIdx.x < PART) l.load(1, k0, r1); } }
    __device__ __forceinline__ void store(bfr* base, int tid) const { r0.st(base, tid); if constexpr (N > 1) { if (PART == 0 || tid < PART) r1.st(base, tid + NTHR); } }
};
template <int BM, int BN, int K, class AL, class BL>
struct GemmPipe {
    static constexpr int WN = BN / 64;
    static constexpr int MI = BM / (32 * (8 / WN));
    static constexpr int ACH = (BM * 4 + NTHR - 1) / NTHR, BCH = BL::template chunks<BN>();
    static constexpr int APART = (BM * 4) % NTHR;
    static constexpr int nk = K / 32;
    static constexpr int ASZ = BM * LSTR, BSZ = BN * LSTR;
    GSlot<AL, ACH, APART> sa0, sa1, sa2;
    GSlot<BL, BCH> sb0, sb1, sb2;
    f32x16 acc[MI][2];
#define G_LOAD(SA, SB, KT) do { SA.load(al, (KT) * 32); SB.load(bl, (KT) * 32); } while (0)
    __device__ __forceinline__ void prefetch(const AL& al, const BL& bl) {
        G_LOAD(sa0, sb0, 0);
        if (1 < nk) G_LOAD(sa1, sb1, 1);
        if constexpr (BL::DEPTH == 3) { if (2 < nk) G_LOAD(sa2, sb2, 2); }
        __builtin_amdgcn_sched_barrier(0);
    }
    __device__ __forceinline__ void mainloop(bfr* smem, const AL& al, const BL& bl) {
        const int tid = threadIdx.x, lane = tid & 63, wave = tid >> 6;
        const int wm = wave / WN, wn = wave % WN;
        bfr* As = smem;
        bfr* Bs3 = smem + 3 * ASZ;
#pragma unroll
        for (int i = 0; i < MI; ++i)
#pragma unroll
            for (int j = 0; j < 2; ++j)
#pragma unroll
                for (int r = 0; r < 16; ++r) acc[i][j][r] = 0.f;
        bf16x8 fa0[2][MI], fb0[2][2], fa1[2][MI], fb1[2][2];
#define G_STORE(SA, SB, BUF) do { SA.store(As + (BUF) * ASZ, tid); SB.store(Bs3 + (BUF) * BSZ, tid); } while (0)
#define G_RD(FA, FB, BUF) do { \
        const bfr* Ab = As + (BUF) * ASZ + (wm * (MI * 32) + (lane & 31)) * LSTR + (lane >> 5) * 8; \
        _Pragma("unroll") for (int ks = 0; ks < 2; ++ks) { \
            _Pragma("unroll") for (int mi = 0; mi < MI; ++mi) FA[ks][mi] = *(const bf16x8*)&Ab[mi * 32 * LSTR + ks * 16]; \
            _Pragma("unroll") for (int ni = 0; ni < 2; ++ni) FB[ks][ni] = BL::frag(Bs3 + (BUF) * BSZ, wn, ni, ks, lane); } } while (0)
#define G_MM(FA, FB) do { \
        _Pragma("unroll") for (int ks = 0; ks < 2; ++ks) \
            _Pragma("unroll") for (int mi = 0; mi < 2; ++mi) \
                _Pragma("unroll") for (int ni = 0; ni < 2; ++ni) \
                    acc[mi][ni] = __builtin_amdgcn_mfma_f32_32x32x16_bf16(FA[ks][mi], FB[ks][ni], acc[mi][ni], 0, 0, 0); } while (0)
#define G_RD1(FA, FB, BUF, KS, I) do { \
        G_RDA(FA, BUF, KS, I); G_RDB(FB, BUF, KS, I); } while (0)
#define G_RDA(FA, BUF, KS, I) FA[KS][I] = *(const bf16x8*)&(As + (BUF) * ASZ + (wm * (MI * 32) + (lane & 31)) * LSTR + (lane >> 5) * 8)[(I) * 32 * LSTR + (KS) * 16]
#define G_RDB(FB, BUF, KS, I) FB[KS][I] = BL::frag(Bs3 + (BUF) * BSZ, wn, I, KS, lane)
#define G_STEP3(J, RBUF, SA, SB, WBUF, DEP) do { const int k = kt + (J); if (k < nk) { \
        G_MM1(fa0, fb0, 0, 0, 0); G_PIN; \
        G_MM1(fa0, fb0, 0, 0, 1); G_PIN; if (k + 1 < nk) { G_RDA(fa0, RBUF, 0, 0); } G_PIN; \
        G_MM1(fa0, fb0, 0, 1, 0); G_PIN; \
        G_MM1(fa0, fb0, 0, 1, 1); G_PIN; if (k + 1 < nk) { G_RDA(fa0, RBUF, 0, 1); } G_PIN; \
        G_MM1(fa0, fb0, 0, 2, 0); G_PIN; if (k + 1 < nk) { G_RDB(fb0, RBUF, 0, 0); } G_PIN; \
        G_MM1(fa0, fb0, 0, 2, 1); G_PIN; if (k + 1 < nk) { G_RDA(fa0, RBUF, 0, 2); G_RDB(fb0, RBUF, 0, 1); } G_PIN; \
        G_MM1(fa0, fb0, 1, 0, 0); G_PIN; if (k + 2 < nk) SA.store(As + (WBUF) * ASZ, tid); G_PIN; \
        G_MM1(fa0, fb0, 1, 0, 1); G_PIN; if (k + 1 < nk) { G_RDA(fa0, RBUF, 1, 0); } if (k + 2 < nk) SB.store(Bs3 + (WBUF) * BSZ, tid); G_PIN; \
        G_MM1(fa0, fb0, 1, 1, 0); G_PIN; if (k + 2 + (DEP) < nk) G_LOAD(SA, SB, k + 2 + (DEP)); G_PIN; \
        G_MM1(fa0, fb0, 1, 1, 1); G_PIN; if (k + 1 < nk) { G_RDA(fa0, RBUF, 1, 1); } G_PIN; \
        G_MM1(fa0, fb0, 1, 2, 0); G_PIN; if (k + 1 < nk) { G_RDB(fb0, RBUF, 1, 0); } G_PIN; \
        G_MM1(fa0, fb0, 1, 2, 1); G_PIN; if (k + 1 < nk) { G_RDA(fa0, RBUF, 1, 2); G_RDB(fb0, RBUF, 1, 1); } \
        __syncthreads(); } } while (0)
#define G_MM1(FA, FB, KS, MI_, NI) acc[MI_][NI] = __builtin_amdgcn_mfma_f32_32x32x16_bf16(FA[KS][MI_], FB[KS][NI], acc[MI_][NI], 0, 0, 0)
#define G_PIN __builtin_amdgcn_sched_barrier(0)
#define G_STEP(J, FAC, FBC, FAN, FBN, RBUF, SA, SB, WBUF, DEP) do { const int k = kt + (J); if (k < nk) { \
        G_MM1(FAC, FBC, 0, 0, 0); G_PIN; if (k + 1 < nk) G_RD1(FAN, FBN, RBUF, 0, 0); G_PIN; \
        G_MM1(FAC, FBC, 0, 0, 1); G_PIN; if (k + 1 < nk) G_RD1(FAN, FBN, RBUF, 0, 1); G_PIN; \
        G_MM1(FAC, FBC, 0, 1, 0); G_PIN; if (k + 1 < nk) G_RD1(FAN, FBN, RBUF, 1, 0); G_PIN; \
        G_MM1(FAC, FBC, 0, 1, 1); G_PIN; if (k + 1 < nk) G_RD1(FAN, FBN, RBUF, 1, 1); G_PIN; \
        G_MM1(FAC, FBC, 1, 0, 0); G_PIN; if (k + 2 < nk) SA.store(As + (WBUF) * ASZ, tid); G_PIN; \
        G_MM1(FAC, FBC, 1, 0, 1); G_PIN; if (k + 2 < nk) SB.store(Bs3 + (WBUF) * BSZ, tid); G_PIN; \
        G_MM1(FAC, FBC, 1, 1, 0); G_PIN; if (k + 2 + (DEP) < nk) G_LOAD(SA, SB, k + 2 + (DEP)); G_PIN; \
        G_MM1(FAC, FBC, 1, 1, 1); \
        __syncthreads(); } } while (0)
        __syncthreads();
        G_STORE(sa0, sb0, 0);
        if (1 < nk) G_STORE(sa1, sb1, 1);
        if (BL::DEPTH < nk) G_LOAD(sa0, sb0, BL::DEPTH);
        if (BL::DEPTH + 1 < nk) G_LOAD(sa1, sb1, BL::DEPTH + 1);
        __builtin_amdgcn_sched_barrier(0);
        __syncthreads();
        G_RD(fa0, fb0, 0);
        if constexpr (BL::DEPTH == 3) {
#pragma unroll
            for (int kt = 0; kt < nk; kt += 6) {
                G_STEP(0, fa0, fb0, fa1, fb1, 1, sa2, sb2, 2, 3);
                G_STEP(1, fa1, fb1, fa0, fb0, 2, sa0, sb0, 0, 3);
                G_STEP(2, fa0, fb0, fa1, fb1, 0, sa1, sb1, 1, 3);
                G_STEP(3, fa1, fb1, fa0, fb0, 1, sa2, sb2, 2, 3);
                G_STEP(4, fa0, fb0, fa1, fb1, 2, sa0, sb0, 0, 3);
                G_STEP(5, fa1, fb1, fa0, fb0, 0, sa1, sb1, 1, 3);
            }
        } else if constexpr (MI == 3) {
#pragma unroll
            for (int kt = 0; kt < nk; kt += 6) {
                G_STEP3(0, 1, sa0, sb0, 2, 2);
                G_STEP3(1, 2, sa1, sb1, 0, 2);
                G_STEP3(2, 0, sa0, sb0, 1, 2);
                G_STEP3(3, 1, sa1, sb1, 2, 2);
                G_STEP3(4, 2, sa0, sb0, 0, 2);
                G_STEP3(5, 0, sa1, sb1, 1, 2);
            }
        } else {
#pragma unroll
            for (int kt = 0; kt < nk; kt += 6) {
                G_STEP(0, fa0, fb0, fa1, fb1, 1, sa0, sb0, 2, 2);
                G_STEP(1, fa1, fb1, fa0, fb0, 2, sa1, sb1, 0, 2);
                G_STEP(2, fa0, fb0, fa1, fb1, 0, sa0, sb0, 1, 2);
                G_STEP(3, fa1, fb1, fa0, fb0, 1, sa1, sb1, 2, 2);
                G_STEP(4, fa0, fb0, fa1, fb1, 2, sa0, sb0, 0, 2);
                G_STEP(5, fa1, fb1, fa0, fb0, 0, sa1, sb1, 1, 2);
            }
        }
#undef G_STORE
#undef G_RD
#undef G_MM
#undef G_STEP
#undef G_STEP3
#undef G_RDA
#undef G_RDB
#undef G_RD1
#undef G_MM1
#undef G_PIN
    }
#undef G_LOAD
    template <class EP> __device__ __forceinline__ void epilogue(bfr* smem, EP& ep) {
        const int lane = threadIdx.x & 63, wave = threadIdx.x >> 6;
        const int wm = wave / WN, wn = wave % WN;
        if constexpr (MI == 3) {
            constexpr int CSTR = BN + 4;
            float* Ct = (float*)smem;
#pragma unroll
            for (int mi = 0; mi < 3; ++mi) {
                if (mi) __syncthreads();
#pragma unroll
                for (int ni = 0; ni < 2; ++ni)
#pragma unroll
                    for (int q = 0; q < 16; ++q)
                        Ct[(wm * 32 + (q & 3) + 8 * (q >> 2) + 4 * (lane >> 5)) * CSTR + wn * 64 + ni * 32 + (lane & 31)] = acc[mi][ni][q];
                __syncthreads();
                ep.template rows3<BN>(Ct, CSTR, mi);
            }
        } else if (ep.direct()) {
#pragma unroll
            for (int mi = 0; mi < 2; ++mi)
#pragma unroll
                for (int ni = 0; ni < 2; ++ni) ep.tile(acc[mi][ni], wm * 64 + mi * 32, wn * 64 + ni * 32, lane, mi, ni);
        } else {
            constexpr int CSTR = BN + 4;
            float* Ct = (float*)smem;
#pragma unroll
            for (int mi = 0; mi < 2; ++mi)
#pragma unroll
                for (int ni = 0; ni < 2; ++ni)
#pragma unroll
                    for (int q = 0; q < 16; ++q)
                        Ct[(wm * 64 + mi * 32 + (q & 3) + 8 * (q >> 2) + 4 * (lane >> 5)) * CSTR + wn * 64 + ni * 32 + (lane & 31)] = acc[mi][ni][q];
            __syncthreads();
            ep.template rows<BM, BN>(Ct, CSTR);
        }
    }
};
constexpr int GEMM_SMEM_ELEMS = 2 * (256 + 128) * LSTR;
constexpr int MOE_TAB_OFF = 133632;

template <int FRAG = 0>
__device__ __forceinline__ void transpose_cvt(const float* W, int K, int N, bfr* WT, int bid, int nb) {
    const size_t total = (size_t)N * (K / 8);
#pragma unroll 1
    for (size_t i = (size_t)bid * NTHR + threadIdx.x; i < total; i += (size_t)nb * NTHR) {
        const int n = (int)(i % N), kc = (int)(i / N);
        float v[8];
#pragma unroll
        for (int j = 0; j < 8; ++j) v[j] = W[(size_t)(kc * 8 + j) * N + n];
        uint4 r; r.x = pack2(v[0], v[1]); r.y = pack2(v[2], v[3]); r.z = pack2(v[4], v[5]); r.w = pack2(v[6], v[7]);
        if (FRAG) *(uint4*)&WT[((size_t)((kc >> 1) * (N / 32) + (n >> 5)) * 64 + (n & 31) + 32 * (kc & 1)) * 8] = r;
        else *(uint4*)&WT[(size_t)n * K + kc * 8] = r;
    }
}

__device__ __forceinline__ void hyena_filter_task(const Params& P, float* sm, int task, int probe = 0) {
    const bool isctx = task >= 512;
    const int l = isctx ? NCTX : LSEQ;
    const int p0 = (isctx ? task - 512 : task) * 32;
    const float* w1 = P.in[15]; const float* b1 = P.in[16]; const float* fq = P.in[17];
    const float* w2 = P.in[18]; const float* b2 = P.in[19]; const float* w3 = P.in[20];
    float* zemb = sm;
    float* h1 = sm + 32 * 33;
    float* h2 = h1 + 32 * 64;
    const int tid = threadIdx.x;
    __syncthreads();
    for (int e = tid; e < 32 * 33; e += NTHR) {
        const int pp = e / 33, i = e % 33;
        const float pos = (float)(p0 + pp);
        float v;
        if (i == 0) v = pos / (float)(l - 1);
        else {
            const int b = (i - 1) & 15;
            const float band = 1e-4f + (float)b * ((15.f - 1e-4f) / 15.f);
            const float ang = ((float)(2.0 * 3.14159265358979323846 / (double)l) * pos) * band;
            v = (i <= 16) ? cosf(ang) : -sinf(ang);
        }
        zemb[e] = v;
    }
    __syncthreads();
    for (int e = tid; e < 32 * 64; e += NTHR) {
        const int pp = e >> 6, j = e & 63;
        float s = b1[j];
#pragma unroll 4
        for (int i = 0; i < 33; ++i) s += zemb[pp * 33 + i] * w1[i * 64 + j];
        h1[e] = sinf(fq[j] * s);
    }
    __syncthreads();
    for (int e = tid; e < 32 * 64; e += NTHR) {
        const int pp = e >> 6, j = e & 63;
        float s = b2[j];
#pragma unroll 4
        for (int i = 0; i < 64; ++i) s += h1[pp * 64 + i] * w2[i * 64 + j];
        h2[e] = sinf(fq[j] * s);
    }
    __syncthreads();
    const float lo = -4.605170185988091f / 1.5f, hi = -4.605170185988091f / 0.3f;
    const float delta = fabsf(lo + (float)tid * ((hi - lo) / 511.f));
    float* HF = isctx ? (float*)(P.ws + WS_HFC) + (size_t)tid * 512 + 256 : (float*)(P.ws + WS_HF) + (size_t)tid * 32768 + LSEQ;
    float asum = 0.f;
#pragma unroll 1
    for (int hp = 0; hp < 2; ++hp) {
        float accf[16], accb[16];
#pragma unroll
        for (int i = 0; i < 16; ++i) { accf[i] = 0.f; accb[i] = 0.f; }
#pragma unroll 2
        for (int k4 = 0; k4 < 16; ++k4) {
            float wf[4], wb[4];
#pragma unroll
            for (int j = 0; j < 4; ++j) { wf[j] = w3[(k4 * 4 + j) * 1024 + tid]; wb[j] = w3[(k4 * 4 + j) * 1024 + 512 + tid]; }
#pragma unroll
            for (int pp = 0; pp < 16; ++pp) {
                const float4 hv = *(const float4*)&h2[(hp * 16 + pp) * 64 + k4 * 4];
                accf[pp] += hv.x * wf[0]; accf[pp] += hv.y * wf[1]; accf[pp] += hv.z * wf[2]; accf[pp] += hv.w * wf[3];
                accb[pp] += hv.x * wb[0]; accb[pp] += hv.y * wb[1]; accb[pp] += hv.z * wb[2]; accb[pp] += hv.w * wb[3];
            }
        }
#pragma unroll
        for (int pp = 0; pp < 16; ++pp) {
            const int pos = p0 + hp * 16 + pp;
            const float t = (float)pos / (float)(l - 1);
            const float win = expf(-t * delta);
            const float f = accf[pp] * win, b = accb[pp] * win;
            HF[pos] = f; asum += fabsf(f);
            if (pos >= 1) { HF[-pos] = b; asum += fabsf(b); }
        }
    }
    ((float*)(P.ws + WS_NORMP))[(size_t)tid * 520 + task] = asum;
}

__device__ __forceinline__ void s5_tables(const Params& P, float* sm, int bid, int nb) {
    const int tid = threadIdx.x;
    if (nb <= 8) return;
    float2* Lam = (float2*)sm;
    float2* Ab = Lam + 64;
    float2* Bb = Ab + 64;
    float2* Cc = Bb + 1024;
    float2* W = Cc + 1024;
    float2* Pw = W + 1024;
    float* Kq = (float*)(Pw + 1024);
    for (int task = bid - 8; task >= 0 && task < 256; task += nb - 8) {
        const int dg = task & 63, q = task >> 6, dir = dg >> 5;
        const float dt = expf(P.in[28][dg]);
        __syncthreads();
        if (tid < 64) {
            const float are = P.in[26][dg * 64 + tid], aim = P.in[27][dg * 64 + tid];
            const float mag1 = expf(are * dt);
            Lam[tid] = make_float2(are, aim); Ab[tid] = make_float2(mag1 * cosf(aim * dt), mag1 * sinf(aim * dt));
        }
        for (int e = tid; e < 1024; e += NTHR) Cc[e] = make_float2(P.in[31][(size_t)dg * 1024 + e], P.in[32][(size_t)dg * 1024 + e]);
        float2 braw[2];
#pragma unroll
        for (int j = 0; j < 2; ++j) { const int e = tid + j * NTHR; braw[j] = make_float2(P.in[29][(size_t)dg * 1024 + e], P.in[30][(size_t)dg * 1024 + e]); }
        __syncthreads();
#pragma unroll
        for (int j = 0; j < 2; ++j) {
            const int e = tid + j * NTHR, pp = e >> 4;
            const float2 lam = Lam[pp], ab = Ab[pp];
            const float nr = ab.x - 1.f, ni = ab.y, den = lam.x * lam.x + lam.y * lam.y;
            const float cr = (nr * lam.x + ni * lam.y) / den, ci = (ni * lam.x - nr * lam.y) / den;
            Bb[e] = make_float2(cr * braw[j].x - ci * braw[j].y, cr * braw[j].y + ci * braw[j].x);
            const int tl = 16 * q + (e >> 6), p2 = e & 63;
            const float ee = (float)(dir == 0 ? tl + 1 : 64 - tl);
            const float2 l2 = Lam[p2];
            const float mg = expf(ee * l2.x * dt);
            Pw[e] = make_float2(mg * cosf(ee * l2.y * dt), mg * sinf(ee * l2.y * dt));
        }
        __syncthreads();
        {
            bfr* E = (bfr*)(P.ws + WS_S5E) + ((size_t)dg * 4 + q) * 64 * 512;
            for (int e_ = tid; e_ < 64 * 64; e_ += NTHR) {
                const int i = e_ >> 6, l = e_ & 63, r = l & 31, h = l >> 5;
                const int pp = (q & 1) * 32 + r, ri = q >> 1;
                const float2 lam = Lam[pp];
                const float ee = (float)(63 - i);
                const float mg = expf(ee * lam.x * dt);
                const float pr = mg * cosf(ee * lam.y * dt), pi = mg * sinf(ee * lam.y * dt);
                float v[8];
#pragma unroll
                for (int jj = 0; jj < 8; ++jj) { const float2 b = Bb[pp * 16 + 8 * h + jj]; v[jj] = ri ? (pr * b.y + pi * b.x) : (pr * b.x - pi * b.y); }
                uint4 pk; pk.x = pack2(v[0], v[1]); pk.y = pack2(v[2], v[3]); pk.z = pack2(v[4], v[5]); pk.w = pack2(v[6], v[7]);
                *(uint4*)&E[(size_t)e_ * 8] = pk;
            }
        }
        {
            bfr* G = (bfr*)(P.ws + WS_S5G) + ((size_t)dg * 32 + 8 * q) * 8 * 512;
            for (int e = tid; e < 4096; e += NTHR) {
                const int ml = e >> 9, ks = (e >> 6) & 7, l = e & 63, r = l & 31, h = l >> 5;
                const int tloc = 2 * ml + (r >> 4), k = r & 15;
                float v[8];
#pragma unroll
                for (int pj = 0; pj < 4; ++pj) {
                    const int pp = ks * 8 + 4 * h + pj;
                    const float2 c = Cc[k * 64 + pp], w = Pw[tloc * 64 + pp];
                    v[2 * pj] = c.x * w.x - c.y * w.y; v[2 * pj + 1] = -(c.x * w.y + c.y * w.x);
                }
                uint4 pk; pk.x = pack2(v[0], v[1]); pk.y = pack2(v[2], v[3]); pk.z = pack2(v[4], v[5]); pk.w = pack2(v[6], v[7]);
                *(uint4*)&G[(size_t)e * 8] = pk;
            }
        }
        float wr[2], wi[2], ar[2], ai[2];
#pragma unroll
        for (int j = 0; j < 2; ++j) {
            const int e = tid + j * NTHR, pp = e >> 4;
            const float2 lam = Lam[pp], ab = Ab[pp], b = Bb[e];
            ar[j] = ab.x; ai[j] = ab.y;
            const float x0 = q ? (float)(16 * q - 1) : 0.f;
            const float mg = expf(x0 * lam.x * dt);
            const float pr = mg * cosf(x0 * lam.y * dt), pi = mg * sinf(x0 * lam.y * dt);
            wr[j] = pr * b.x - pi * b.y; wi[j] = pr * b.y + pi * b.x;
        }
        for (int sidx = 0; sidx < 17; ++sidx) {
            if (q == 0 && sidx == 0) { if (tid < 256) Kq[tid] = 0.f; continue; }
            __syncthreads();
#pragma unroll
            for (int j = 0; j < 2; ++j) W[tid + j * NTHR] = make_float2(wr[j], wi[j]);
            __syncthreads();
            {
                const int o = tid & 255, k = o >> 4, kk = o & 15, p0 = (tid >> 8) * 32;
                float accv = 0.f;
#pragma unroll 8
                for (int pp = p0; pp < p0 + 32; ++pp) { const float2 c = Cc[k * 64 + pp], w = W[pp * 16 + kk]; accv += c.x * w.x - c.y * w.y; }
                if (tid >= 256) Kq[17 * 256 + o] = accv;
                __syncthreads();
                if (tid < 256) Kq[sidx * 256 + o] = accv + Kq[17 * 256 + o];
            }
#pragma unroll
            for (int j = 0; j < 2; ++j) { const float nr = wr[j] * ar[j] - wi[j] * ai[j], ni = wr[j] * ai[j] + wi[j] * ar[j]; wr[j] = nr; wi[j] = ni; }
        }
        __syncthreads();
        {
            bfr* F = (bfr*)(P.ws + WS_S5F) + ((size_t)dg * 64 + 16 * q) * 512;
            for (int e = tid; e < 1024; e += NTHR) {
                const int fl = e >> 6, l = e & 63, r = l & 31, h = l >> 5, ts = r >> 4, k = r & 15;
                const int sidx = dir == 0 ? fl + ts : fl - ts + 1;
                const float* kp = Kq + sidx * 256 + k * 16 + 8 * h;
                uint4 pk; pk.x = pack2(kp[0], kp[1]); pk.y = pack2(kp[2], kp[3]); pk.z = pack2(kp[4], kp[5]); pk.w = pack2(kp[6], kp[7]);
                *(uint4*)&F[(size_t)e * 8] = pk;
            }
        }
    }
    __syncthreads();
}

__device__ __forceinline__ void phase_prologue(const Params& P, float* sm, int bid, int nb, int probe = 0) {
    const int tid = threadIdx.x;
    for (int rep2 = (PROBE_DUP == 101 ? 0 : 1); rep2 < 2; ++rep2) {
    for (int task = bid; task < 192; task += nb) {
        const int layer = task / 96, j0 = (task % 96) * 64;
        float* sv = sm;
        float* red = sm + 2048;
        __syncthreads();
        for (int e = tid; e < 2048; e += NTHR) { const float c = (e < 1024) ? P.in[3][e] : P.in[1][e - 1024]; sv[e] = siluf_(c); }
        __syncthreads();
        const int jj = tid & 63, ks = tid >> 6;
        const float* w = P.in[4] + (size_t)layer * 1024 * 6144 + j0 + jj;
        float a0 = 0.f, a1 = 0.f;
#pragma unroll 8
        for (int k = ks * 128; k < ks * 128 + 128; ++k) { const float wv = w[(size_t)k * 6144]; a0 += sv[k] * wv; a1 += sv[1024 + k] * wv; }
        red[(ks * 64 + jj) * 2] = a0; red[(ks * 64 + jj) * 2 + 1] = a1;
        __syncthreads();
        if (tid < 128) {
            const int j = tid & 63, wh = tid >> 6;
            float s = 0.f;
            for (int q = 0; q < 8; ++q) s += red[(q * 64 + j) * 2 + wh];
            ((float*)(P.ws + WS_MOD))[(size_t)(layer * 2 + wh) * 6144 + j0 + j] = s + P.in[5][layer * 6144 + j0 + j];
        }
    }
    transpose_cvt(P.in[10], 1024, 3072, (bfr*)(P.ws + WS_WINT0), bid, nb);
    transpose_cvt(P.in[11], 1024, 1024, (bfr*)(P.ws + WS_WOUTT0), bid, nb);
    transpose_cvt(P.in[22], 1024, 1280, (bfr*)(P.ws + WS_WINT1), bid, nb);
    transpose_cvt(P.in[23], 1024, 1024, (bfr*)(P.ws + WS_WOUTT1), bid, nb);
    transpose_cvt<1>(P.in[36], 1024, 256, (bfr*)(P.ws + WS_ROUT), bid, nb);
    transpose_cvt<1>(P.in[36] + 1024 * 256, 1024, 256, (bfr*)(P.ws + WS_ROUT) + 256 * 1024, bid, nb);
    transpose_cvt(P.in[34], 512, 512, (bfr*)(P.ws + WS_GLUT), bid, nb);
    }
    for (int rep = (PROBE_DUP == 100 ? 0 : 1); rep < 2; ++rep)
        for (int task = bid; task < 520; task += nb) hyena_filter_task(P, sm, task, rep == 0 ? 1 : 0);
    s5_tables(P, sm, bid, nb);
    for (int i = bid * NTHR + tid; i < 4096; i += nb * NTHR) {
        const int dg = i >> 6, p = i & 63;
        const float are = P.in[26][i], aim = P.in[27][i];
        const float dt = expf(P.in[28][dg]);
        const float mag = expf(are * dt);
        const float abr = mag * cosf(aim * dt), abi = mag * sinf(aim * dt);
        ((float2*)(P.ws + WS_ABAR))[i] = make_float2(abr, abi);
        float xr = abr, xi = abi;
#pragma unroll
        for (int q = 0; q < 6; ++q) { const float nr = xr * xr - xi * xi, ni = 2.f * xr * xi; xr = nr; xi = ni; }
        ((float2*)(P.ws + WS_A64))[i] = make_float2(xr, xi);
        const float nr = abr - 1.f, ni = abi, den = are * are + aim * aim;
        const float cr = (nr * are + ni * aim) / den, ci = (ni * are - nr * aim) / den;
        float2* bb = (float2*)(P.ws + WS_BBAR) + (size_t)i * 16;
#pragma unroll 4
        for (int k = 0; k < 16; ++k) {
            const float br = P.in[29][(size_t)i * 16 + k], bi = P.in[30][(size_t)i * 16 + k];
            bb[k] = make_float2(cr * br - ci * bi, cr * bi + ci * br);
        }
        bfr* cm = (bfr*)(P.ws + WS_CMAT) + (size_t)dg * 16 * 128;
#pragma unroll 4
        for (int n = 0; n < 16; ++n) {
            const float c_re = P.in[31][((size_t)dg * 16 + n) * 64 + p], c_im = P.in[32][((size_t)dg * 16 + n) * 64 + p];
            cm[n * 128 + 2 * p] = f2bf(c_re); cm[n * 128 + 2 * p + 1] = f2bf(-c_im);
        }
    }
}

__device__ __forceinline__ void phase_h0(const Params& P, int bid, int nb) {
    const float* mod = (const float*)(P.ws + WS_MOD);
    bfr* H = (bfr*)(P.ws + WS_H);
    const size_t total = (size_t)NT * 128;
    for (size_t i = (size_t)bid * NTHR + threadIdx.x; i < total; i += (size_t)nb * NTHR) {
        const int row = (int)(i >> 7), c0 = (int)(i & 127) * 8;
        const int wh = row >= NCTX;
        const float* src = wh ? P.in[0] + (size_t)(row - NCTX) * 1024 + c0 : P.in[2] + (size_t)row * 1024 + c0;
        const float* sh = mod + (size_t)wh * 6144 + c0;
        const float* sc = sh + 1024;
        const float4 a = *(const float4*)src, b = *(const float4*)(src + 4);
        const float4 s0 = *(const float4*)sc, s1 = *(const float4*)(sc + 4);
        const float4 h0 = *(const float4*)sh, h1 = *(const float4*)(sh + 4);
        uint4 r;
        r.x = pack2(a.x * (1.f + s0.x) + h0.x, a.y * (1.f + s0.y) + h0.y);
        r.y = pack2(a.z * (1.f + s0.z) + h0.z, a.w * (1.f + s0.w) + h0.w);
        r.z = pack2(b.x * (1.f + s1.x) + h1.x, b.y * (1.f + s1.y) + h1.y);
        r.w = pack2(b.z * (1.f + s1.z) + h1.z, b.w * (1.f + s1.w) + h1.w);
        *(uint4*)&H[(size_t)row * 1024 + c0] = r;
    }
}

#define ROWS_LOOP(BM_, BN_) for (int id_ = threadIdx.x; id_ < (BM_) * (BN_) / 8; id_ += NTHR)
__device__ __forceinline__ void ld8(const float* p, float* v) {
    const float4 a = *(const float4*)p, b = *(const float4*)(p + 4);
    v[0] = a.x; v[1] = a.y; v[2] = a.z; v[3] = a.w; v[4] = b.x; v[5] = b.y; v[6] = b.z; v[7] = b.w;
}
__device__ __forceinline__ void up8(const uint4 v, float* f) {
    f[0] = bflo(v.x); f[1] = bfhi(v.x); f[2] = bflo(v.y); f[3] = bfhi(v.y); f[4] = bflo(v.z); f[5] = bfhi(v.z); f[6] = bflo(v.w); f[7] = bfhi(v.w);
}
__device__ __forceinline__ uint4 pack8(const float* v) { uint4 r; r.x = pack2(v[0], v[1]); r.y = pack2(v[2], v[3]); r.z = pack2(v[4], v[5]); r.w = pack2(v[6], v[7]); return r; }

struct EpiBf16 {
    bfr* C; int ld; int row0, col0, maxrow;
    __device__ __forceinline__ bool direct() const { return false; }
    __device__ __forceinline__ void tile(const f32x16&, int, int, int, int, int) {}
    template <int BM, int BN> __device__ __forceinline__ void rows(const float* Ct, int cstr) {
        ROWS_LOOP(BM, BN) {
            const int r = id_ / (BN / 8), c = (id_ % (BN / 8)) * 8;
            const int row = row0 + r;
            float v[8]; ld8(Ct + r * cstr + c, v);
            if (row <= maxrow) *(uint4*)&C[(size_t)row * ld + col0 + c] = pack8(v);
        }
    }
};
__device__ __forceinline__ void phase_gemm_bf16out(const bfr* A, int lda, int m0, int M, const bfr* Bt, int N, int K, bfr* C, int ldc, bfr* smem, int bid, int nb) {
    const int mt = (M + 255) / 256, nt = N / 128, nu = mt * nt;
    GemmPipe<256, 128, 1024, ALoadRows, BLoadT> gp;
    ALoadRows al; BLoadT bl;
    int u = bid;
    if (u < nu) { al.init<256>(A, lda, m0 + (u / nt) * 256, m0 + M - 1, nullptr); bl.init<128>(Bt, K, (u % nt) * 128); gp.prefetch(al, bl); }
    while (u < nu) {
        EpiBf16 ep{C, ldc, m0 + (u / nt) * 256, (u % nt) * 128, m0 + M - 1};
        gp.mainloop(smem, al, bl);
        const int un = u + nb;
        if (un < nu) { al.init<256>(A, lda, m0 + (un / nt) * 256, m0 + M - 1, nullptr); bl.init<128>(Bt, K, (un % nt) * 128); gp.prefetch(al, bl); }
        gp.epilogue(smem, ep);
        u = un;
    }
}
struct EpiInProj0 {
    bfr* C; bfr* VT; bfr* KF; int row0, col0;
    __device__ __forceinline__ bool direct() const { return col0 >= 1024 && col0 < 1536; }
    __device__ __forceinline__ void tile(const f32x16& a, int rb, int cb, int lane, int, int) {
        const int colv = col0 + cb + (lane & 31) - 1024;
        const int head = colv >> 6, dt = (colv >> 5) & 1, r = colv & 31;
#pragma unroll
        for (int g4 = 0; g4 < 4; ++g4) {
            const int t0 = row0 + rb + 8 * g4 + 4 * (lane >> 5);
            const int kb = t0 >> 4, pos0 = t0 & 15;
            uint2 pk; pk.x = pack2(a[g4 * 4], a[g4 * 4 + 1]); pk.y = pack2(a[g4 * 4 + 2], a[g4 * 4 + 3]);
            *(uint2*)&VT[((((size_t)head * (NT / 16) + kb) * 2 + dt) * 64 + r + 32 * ((pos0 >> 2) & 1)) * 8 + (pos0 >> 3) * 4] = pk;
        }
    }
    template <int BM, int BN> __device__ __forceinline__ void rows(const float* Ct, int cstr) {
        ROWS_LOOP(BM, BN) {
            const int r = id_ / (BN / 8), c = (id_ % (BN / 8)) * 8;
            float v[8]; ld8(Ct + r * cstr + c, v);
            const int t = row0 + r, col = col0 + c;
            if (col0 >= 512 && col0 < 1024) {
                const int colk = col - 512, head = colk >> 6, dd0 = colk & 63;
                *(uint4*)&KF[((((size_t)head * (NT / 32) + (t >> 5)) * 4 + (dd0 >> 4)) * 64 + (t & 31) + 32 * ((dd0 >> 3) & 1)) * 8] = pack8(v);
            } else *(uint4*)&C[(size_t)t * 3072 + col] = pack8(v);
        }
    }
};
__device__ __forceinline__ void phase_inproj0(const Params& P, bfr* smem, int bid, int nb) {
    const bfr* A = (const bfr*)(P.ws + WS_H);
    const bfr* Bt = (const bfr*)(P.ws + WS_WINT0);
    constexpr int nu = 65 * 24;
    GemmPipe<256, 128, 1024, ALoadRows, BLoadT> gp;
    ALoadRows al; BLoadT bl;
    int u = bid;
    if (u < nu) { al.init<256>(A, 1024, (u / 24) * 256, NT - 1, nullptr); bl.init<128>(Bt, 1024, (u % 24) * 128); gp.prefetch(al, bl); }
    while (u < nu) {
        EpiInProj0 ep{(bfr*)(P.ws + WS_QKVU), (bfr*)(P.ws + WS_VT0), (bfr*)(P.ws + WS_K0F), (u / 24) * 256, (u % 24) * 128};
        gp.mainloop(smem, al, bl);
        const int un = u + nb;
        if (un < nu) { al.init<256>(A, 1024, (un / 24) * 256, NT - 1, nullptr); bl.init<128>(Bt, 1024, (un % 24) * 128); gp.prefetch(al, bl); }
        gp.epilogue(smem, ep);
        u = un;
    }
}
struct EpiOutProj {
    const float* xc; const float* xl; const bfr* x2; const float* mod; bfr* PRE; int row0, col0;
    __device__ __forceinline__ bool direct() const { return false; }
    __device__ __forceinline__ void tile(const f32x16&, int, int, int, int, int) {}
    template <int BM, int BN> __device__ __forceinline__ void rows(const float* Ct, int cstr) {
        ROWS_LOOP(BM, BN) {
            const int r = id_ / (BN / 8), c = (id_ % (BN / 8)) * 8;
            const int row = row0 + r, col = col0 + c;
            if (row < NT) {
                const int wh = row >= NCTX;
                float v[8], x[8], g[8]; ld8(Ct + r * cstr + c, v);
                if (x2) {
                    const uint4 xx = *(const uint4*)(x2 + (size_t)row * 1024 + col);
                    x[0] = bflo(xx.x); x[1] = bfhi(xx.x); x[2] = bflo(xx.y); x[3] = bfhi(xx.y); x[4] = bflo(xx.z); x[5] = bfhi(xx.z); x[6] = bflo(xx.w); x[7] = bfhi(xx.w);
                } else ld8(wh ? xl + (size_t)(row - NCTX) * 1024 + col : xc + (size_t)row * 1024 + col, x);
                ld8(mod + (size_t)wh * 6144 + 2048 + col, g);
#pragma unroll
                for (int j = 0; j < 8; ++j) v[j] = ALPHA * x[j] + g[j] * v[j];
                *(uint4*)(PRE + (size_t)row * 1024 + col) = pack8(v);
            }
        }
    }
};
__device__ __forceinline__ void phase_outproj(const Params& P, int layer, bfr* smem, int bid, int nb) {
    const bfr* A = (const bfr*)(P.ws + WS_ATT);
    const bfr* Bt = (const bfr*)(P.ws + (layer ? WS_WOUTT1 : WS_WOUTT0));
    const float* mod = (const float*)(P.ws + WS_MOD) + (size_t)layer * 2 * 6144;
    const float* xc = P.in[2];
    const float* xl = P.in[0];
    const bfr* x2 = layer ? (const bfr*)(P.ws + WS_X2) : nullptr;
    const int m0 = layer ? NCTX : 0, M = NT - m0;
    const int mt = (M + 255) / 256, nu = mt * 8;
    GemmPipe<256, 128, 1024, ALoadRows, BLoadT> gp;
    ALoadRows al; BLoadT bl;
    int u = bid;
    if (u < nu) { al.init<256>(A, 1024, m0 + (u >> 3) * 256, NT - 1, nullptr); bl.init<128>(Bt, 1024, (u & 7) * 128); gp.prefetch(al, bl); }
    while (u < nu) {
        EpiOutProj ep{xc, xl, x2, mod, (bfr*)(P.ws + WS_PRE), m0 + (u >> 3) * 256, (u & 7) * 128};
        gp.mainloop(smem, al, bl);
        const int un = u + nb;
        if (un < nu) { al.init<256>(A, 1024, m0 + (un >> 3) * 256, NT - 1, nullptr); bl.init<128>(Bt, 1024, (un & 7) * 128); gp.prefetch(al, bl); }
        gp.epilogue(smem, ep);
        u = un;
    }
}

__device__ __forceinline__ void phase_na_attention(const Params& P, float* sm, int bid, int nb) {
    const bfr* QK = (const bfr*)(P.ws + WS_QKVU);
    const bfr* VT = (const bfr*)(P.ws + WS_VT0);
    const bfr* KF = (const bfr*)(P.ws + WS_K0F);
    bfr* ATT = (bfr*)(P.ws + WS_ATT);
    const float* rpb = P.in[12];
    const int lane = threadIdx.x & 63, wave = threadIdx.x >> 6, r = lane & 31, h = lane >> 5;
    const float SC = 0.125f * 1.4426950408889634f, L2E = 1.4426950408889634f;
    __syncthreads();
    for (int e = threadIdx.x; e < 8 * 15 * 31; e += NTHR) sm[e] = P.in[12][e] * L2E;
    __syncthreads();
    for (int task = bid * 8 + wave; task < 260 * 16; task += nb * 8) {
        const int qh = task & 1, head = (task >> 1) & 7, blk = task >> 4;
        const bool lat = blk >= 4;
        const int rr = blk - 4;
        const int tok = blk * 64 + qh * 32 + r;
        const int c = qh * 32 + r;
        const int cs = min(max(c - 8, 0), 48), rs = min(max(rr - 4, 0), 248);
        bf16x8 qf[4];
#pragma unroll
        for (int ks = 0; ks < 4; ++ks) qf[ks] = *(const bf16x8*)(QK + (size_t)tok * 3072 + head * 64 + ks * 16 + h * 8);
        f32x16 o[2];
#pragma unroll
        for (int i = 0; i < 2; ++i)
#pragma unroll
            for (int q = 0; q < 16; ++q) o[i][q] = 0.f;
        float m = -1e30f, l = 0.f;
        const int ntiles = lat ? 12 : 4;
        bf16x8 kf[2][4];
        {
            const int krow0 = lat ? NCTX + rs * 64 : 0;
#pragma unroll
            for (int kt = 0; kt < 2; ++kt)
#pragma unroll
                for (int ks = 0; ks < 4; ++ks) kf[kt][ks] = *(const bf16x8*)(KF + ((((size_t)head * (NT / 32) + (krow0 >> 5) + kt) * 4 + ks) * 64 + lane) * 8);
        }
        for (int ti = 0; ti < ntiles; ++ti) {
            const bool win = lat && ti < 8;
            const int krow0 = win ? NCTX + (rs + ti) * 64 : (lat ? ti - 8 : ti) * 64;
            bf16x8 vfr[2][2][2];
#pragma unroll
            for (int dt = 0; dt < 2; ++dt)
#pragma unroll
                for (int kt = 0; kt < 2; ++kt)
#pragma unroll
                    for (int s2 = 0; s2 < 2; ++s2)
                        vfr[dt][kt][s2] = *(const bf16x8*)(VT + ((((size_t)head * (NT / 16) + (krow0 >> 4) + kt * 2 + s2) * 2 + dt) * 64 + lane) * 8);
            f32x16 s[2];
#pragma unroll
            for (int kt = 0; kt < 2; ++kt) {
#pragma unroll
                for (int q = 0; q < 16; ++q) s[kt][q] = 0.f;
#pragma unroll
                for (int ks = 0; ks < 4; ++ks) s[kt] = __builtin_amdgcn_mfma_f32_32x32x16_bf16(kf[kt][ks], qf[ks], s[kt], 0, 0, 0);
            }
            if (ti + 1 < ntiles) {
                const bool win1 = lat && ti + 1 < 8;
                const int krow1 = win1 ? NCTX + (rs + ti + 1) * 64 : (lat ? ti + 1 - 8 : ti + 1) * 64;
#pragma unroll
                for (int kt = 0; kt < 2; ++kt)
#pragma unroll
                    for (int ks = 0; ks < 4; ++ks) kf[kt][ks] = *(const bf16x8*)(KF + ((((size_t)head * (NT / 32) + (krow1 >> 5) + kt) * 4 + ks) * 64 + lane) * 8);
            }
            if (win) {
                const float* rp = sm + (head * 15 + (rs + ti - rr + 7)) * 31 - c + 15;
#pragma unroll
                for (int kt = 0; kt < 2; ++kt)
#pragma unroll
                    for (int q = 0; q < 16; ++q) {
                        const int kc = kt * 32 + (q & 3) + 8 * (q >> 2) + 4 * h;
                        const bool in = (kc >= cs) && (kc < cs + 16);
                        const float bias = rp[in ? kc : c];
                        s[kt][q] = in ? s[kt][q] * SC + bias : -1e30f;
                    }
            } else {
#pragma unroll
                for (int kt = 0; kt < 2; ++kt)
#pragma unroll
                    for (int q = 0; q < 16; ++q) s[kt][q] *= SC;
            }
            float mxp[4];
#pragma unroll
            for (int i = 0; i < 4; ++i) mxp[i] = fmaxf(s[0][i], s[1][i]);
#pragma unroll
            for (int q = 4; q < 16; ++q) mxp[q & 3] = fmaxf(mxp[q & 3], fmaxf(s[0][q], s[1][q]));
            float mx = fmaxf(fmaxf(mxp[0], mxp[1]), fmaxf(mxp[2], mxp[3]));
            mx = fmaxf(mx, __shfl_xor(mx, 32, 64));
            const float mn = fmaxf(m, mx);
            const float alpha = __builtin_amdgcn_exp2f(m - mn);
            l *= alpha;
#pragma unroll
            for (int q = 0; q < 16; ++q) { o[0][q] *= alpha; o[1][q] *= alpha; }
            m = mn;
            bf16x8 pf[2][2];
#pragma unroll
            for (int kt = 0; kt < 2; ++kt)
#pragma unroll
                for (int s2 = 0; s2 < 2; ++s2) {
                    float pv[8];
#pragma unroll
                    for (int j = 0; j < 8; ++j) pv[j] = __builtin_amdgcn_exp2f(s[kt][s2 * 8 + j] - m);
                    l += ((pv[0] + pv[1]) + (pv[2] + pv[3])) + ((pv[4] + pv[5]) + (pv[6] + pv[7]));
                    union { uint4 u; bf16x8 v; } cv;
                    cv.u.x = pack2(pv[0], pv[1]); cv.u.y = pack2(pv[2], pv[3]); cv.u.z = pack2(pv[4], pv[5]); cv.u.w = pack2(pv[6], pv[7]);
                    pf[kt][s2] = cv.v;
                }
#pragma unroll
            for (int dt = 0; dt < 2; ++dt)
#pragma unroll
                for (int kt = 0; kt < 2; ++kt)
#pragma unroll
                    for (int s2 = 0; s2 < 2; ++s2)
                        o[dt] = __builtin_amdgcn_mfma_f32_32x32x16_bf16(vfr[dt][kt][s2], pf[kt][s2], o[dt], 0, 0, 0);
        }
        l += __shfl_xor(l, 32, 64);
        const float inv = 1.f / l;
        bfr* op = ATT + (size_t)tok * 1024 + head * 64;
#pragma unroll
        for (int dt = 0; dt < 2; ++dt)
#pragma unroll
            for (int g4 = 0; g4 < 4; ++g4) {
                uint2 pk;
                pk.x = pack2(o[dt][g4 * 4 + 0] * inv, o[dt][g4 * 4 + 1] * inv);
                pk.y = pack2(o[dt][g4 * 4 + 2] * inv, o[dt][g4 * 4 + 3] * inv);
                *(uint2*)(op + dt * 32 + g4 * 8 + h * 4) = pk;
            }
    }
}

__device__ __forceinline__ float short_conv(const bfr* QK, const float* cw, const float* cb, int row, int cc, int seg0, int seg1) {
    const bfr* u = QK + (size_t)row * 3072 + 1536 + cc;
    float s = cb[cc] + bf2f(u[0]) * cw[1536 + cc];
    if (row - 1 >= seg0) s += bf2f(u[-3072]) * cw[cc];
    if (row + 1 < seg1) s += bf2f(u[3072]) * cw[2 * 1536 + cc];
    return s;
}

__device__ __forceinline__ void phase_zprep(const Params& P, float* sm, int bid, int nb) {
    const bfr* QK = (const bfr*)(P.ws + WS_QKVU);
    float* Z = (float*)(P.ws + WS_Z);
    float* X0 = (float*)(P.ws + WS_X0);
    const float* cw = P.in[13]; const float* cb = P.in[14];
    const int tid = threadIdx.x;
    float* sz = sm; float* sx = sm + 512 * 33;
    float w0[3], w1[3], w2[3], bs[3];
#pragma unroll
    for (int g = 0; g < 3; ++g) { const int cc = g * 512 + tid; w0[g] = cw[cc]; w1[g] = cw[1536 + cc]; w2[g] = cw[2 * 1536 + cc]; bs[g] = cb[cc]; }
    for (int u = bid; u < NT / 32; u += nb) {
        const int r0 = u * 32;
        const int seg0 = r0 < NCTX ? 0 : NCTX, seg1 = r0 < NCTX ? NCTX : NT;
        const bfr* up = QK + (size_t)r0 * 3072 + 1536 + tid;
        float pv[3], cv[3];
#pragma unroll
        for (int g = 0; g < 3; ++g) { pv[g] = (r0 - 1 >= seg0) ? bf2f(up[g * 512 - 3072]) : 0.f; cv[g] = bf2f(up[g * 512]); }
        __syncthreads();
#pragma unroll 8
        for (int tt = 0; tt < 32; ++tt) {
            float nv[3], y[3];
#pragma unroll
            for (int g = 0; g < 3; ++g) {
                nv[g] = (r0 + tt + 1 < seg1) ? bf2f(up[(size_t)(tt + 1) * 3072 + g * 512]) : 0.f;
                y[g] = bs[g] + pv[g] * w0[g] + cv[g] * w1[g] + nv[g] * w2[g];
                pv[g] = cv[g]; cv[g] = nv[g];
            }
            sz[tid * 33 + tt] = y[1] * y[2];
            sx[tid * 33 + tt] = y[0];
        }
        __syncthreads();
        for (int e = tid; e < 512 * 32; e += NTHR) {
            const int c = e >> 5, tt = e & 31;
            Z[(size_t)c * NT + r0 + tt] = sz[c * 33 + tt];
            X0[(size_t)c * NT + r0 + tt] = sx[c * 33 + tt];
        }
    }
}

#define HZ_STR 136
#define HC_LEN 2208
__device__ __forceinline__ void phase_longconv(const Params& P, unsigned char* smraw, int bid, int nb) {
    const bfr* QK = (const bfr*)(P.ws + WS_QKVU);
    const float* Z = (const float*)(P.ws + WS_Z);
    const float* HF = (const float*)(P.ws + WS_HF);
    const float* HFC = (const float*)(P.ws + WS_HFC);
    const float* X0 = (const float*)(P.ws + WS_X0);
    const float* cw = P.in[13]; const float* cb = P.in[14]; const float* skip = P.in[21];
    bfr* ATT = (bfr*)(P.ws + WS_ATT);
    const int tid = threadIdx.x, lane = tid & 63, wave = tid >> 6, r = lane & 31, h = lane >> 5;
    {
        bfr* Zs = (bfr*)smraw;
        bfr* Cs = Zs + 129 * HZ_STR;
        float* Red = (float*)smraw;
        const int bh = wave & 1, kh = (wave >> 1) & 1, ah = wave >> 2;
        const int lw = bh + 2 * ah + 4 * kh;
        for (int c = bid; c < 512; c += nb) {
            __syncthreads();
            for (int e = tid; e < 128 * 32; e += NTHR) {
                const int row = e >> 5, d4 = (e & 31) * 4;
                const float4 v = *(const float4*)(Z + (size_t)c * NT + NCTX + row * 128 + d4);
                uint2 pk; pk.x = pack2(v.x, v.y); pk.y = pack2(v.z, v.w);
                *(uint2*)&Zs[row * HZ_STR + d4] = pk;
            }
            if (tid < HZ_STR / 2) ((unsigned*)&Zs[128 * HZ_STR])[tid] = 0u;
            f32x16 acc[2][2];
#pragma unroll
            for (int i = 0; i < 2; ++i)
#pragma unroll
                for (int j = 0; j < 2; ++j)
#pragma unroll
                    for (int q = 0; q < 16; ++q) acc[i][j][q] = 0.f;
            const float* hf = HF + (size_t)c * 32768 + LSEQ;
            float w0[3], w1[3], w2[3];
#define HY_LOADW(GI) do { const int M_ = 128 * (16 * (GI) - 112); \
                _Pragma("unroll") for (int it = 0; it < 3; ++it) { const int tt_ = tid + it * NTHR; const int i0 = M_ - 2 * (tt_ - 4); \
                    w0[it] = (tt_ < 1108 && i0 > -LSEQ && i0 < LSEQ) ? hf[i0] : 0.f; \
                    w1[it] = (tt_ < 1108 && i0 - 1 > -LSEQ && i0 - 1 < LSEQ) ? hf[i0 - 1] : 0.f; \
                    w2[it] = (tt_ < 1108 && i0 - 2 > -LSEQ && i0 - 2 < LSEQ) ? hf[i0 - 2] : 0.f; } } while (0)
            HY_LOADW(0);
            for (int gi = 0; gi < 16; ++gi) {
                const int k0 = -128 + gi * 16;
                bfr* Cg = Cs + (gi & 1) * 8 * HC_LEN;
#pragma unroll
                for (int it = 0; it < 3; ++it) {
                    const int tt_ = tid + it * NTHR, t2 = 2 * (tt_ - 4);
                    if (tt_ < 1108) {
                        const unsigned pe = pack2(w0[it], w1[it]), po = pack2(w1[it], w2[it]);
#pragma unroll
                        for (int rho = 0; rho < 8; rho += 2) {
                            const int xe = t2 + rho, xo = t2 + rho + 2;
                            if (xe >= 0 && xe < HC_LEN) *(unsigned*)&Cg[rho * HC_LEN + xe] = pe;
                            if (xo >= 0 && xo < HC_LEN) *(unsigned*)&Cg[(rho + 1) * HC_LEN + xo] = po;
                        }
                    }
                }
                if (gi + 1 < 16) HY_LOADW(gi + 1);
                __syncthreads();
                const int a00 = ah * 64, a01 = ah * 64 + 32;
                if (k0 + 15 > a00 - 128 && k0 <= a01 + 31) {
                    bf16x8 fA[2][2], fB[2][2], gA[2][2], gB[2][2];
#define HY_LOAD(FA, FB, KK, HALF) do { const int k_ = k0 + (KK); \
                        const int row0_ = a00 + r - k_, row1_ = a01 + r - k_; \
                        const int zo0_ = (((k_ <= a00 + 31) && (k_ > a00 - 128) && (unsigned)row0_ < 128u) ? row0_ : 128) * HZ_STR + h * 8; \
                        const int zo1_ = (((k_ <= a01 + 31) && (k_ > a01 - 128) && (unsigned)row1_ < 128u) ? row1_ : 128) * HZ_STR + h * 8; \
                        const int xb_ = (gi & 1) * 8 * HC_LEN + (r & 7) * HC_LEN + 128 * (16 - (KK)) - (bh * 64) - (r & ~7) + h * 8 + kh * 64; \
                        _Pragma("unroll") for (int d2 = 0; d2 < 2; ++d2) { const int dbi = (HALF) * 2 + d2; \
                            FA[d2][0] = *(const bf16x8*)&Cs[xb_ + dbi * 16]; FA[d2][1] = *(const bf16x8*)&Cs[xb_ + dbi * 16 - 32]; \
                            FB[d2][0] = *(const bf16x8*)&Zs[zo0_ + kh * 64 + dbi * 16]; FB[d2][1] = *(const bf16x8*)&Zs[zo1_ + kh * 64 + dbi * 16]; } \
                        __builtin_amdgcn_sched_barrier(0); } while (0)
#define HY_MM(FA, FB) do { \
                        _Pragma("unroll") for (int d2 = 0; d2 < 2; ++d2) { \
                            acc[0][0] = __builtin_amdgcn_mfma_f32_32x32x16_bf16(FA[d2][0], FB[d2][0], acc[0][0], 0, 0, 0); \
                            acc[1][0] = __builtin_amdgcn_mfma_f32_32x32x16_bf16(FA[d2][1], FB[d2][0], acc[1][0], 0, 0, 0); \
                            acc[0][1] = __builtin_amdgcn_mfma_f32_32x32x16_bf16(FA[d2][0], FB[d2][1], acc[0][1], 0, 0, 0); \
                            acc[1][1] = __builtin_amdgcn_mfma_f32_32x32x16_bf16(FA[d2][1], FB[d2][1], acc[1][1], 0, 0, 0); } \
                        __builtin_amdgcn_sched_barrier(0); } while (0)
                    HY_LOAD(fA, fB, 0, 0);
#pragma unroll
                    for (int kk = 0; kk < 16; ++kk) {
                        HY_LOAD(gA, gB, kk, 1);
                        HY_MM(fA, fB);
                        if (kk + 1 < 16) HY_LOAD(fA, fB, kk + 1, 0);
                        HY_MM(gA, gB);
                    }
#undef HY_LOAD
#undef HY_MM
                }
            }
            __syncthreads();
#pragma unroll
            for (int i = 0; i < 2; ++i)
#pragma unroll
                for (int j = 0; j < 2; ++j)
#pragma unroll
                    for (int q = 0; q < 16; ++q) Red[(lw * 64 + (i * 2 + j) * 16 + q) * 64 + lane] = acc[i][j][q];
            __syncthreads();
            {
                const float part = wave_sum(((const float*)(P.ws + WS_NORMP))[(size_t)c * 520 + tid]);
                float* nred = Red + 8 * 64 * 64;
                if (lane == 0) nred[wave] = part;
                __syncthreads();
                float ntot = 0.f;
#pragma unroll
                for (int w_ = 0; w_ < 8; ++w_) ntot += nred[w_];
                const float nrm = 1.f / ntot;
                const float sk = skip[c];
                for (int t = tid; t < LSEQ; t += NTHR) {
                    const int b = t & 127, a_ = t >> 7;
                    const int bt = b >> 5, rb = b & 31, at = a_ >> 5;
                    const int hh = (rb >> 2) & 1, q = (rb & 3) + 4 * (rb >> 3);
                    const int w = (bt >> 1) + 2 * (at >> 1);
                    const int idx = (w * 64 + ((bt & 1) * 2 + (at & 1)) * 16 + q) * 64 + (a_ & 31) + 32 * hh;
                    const float v = Red[idx] + Red[idx + 4 * 64 * 64];
                    const int row = NCTX + t;
                    const float x0 = X0[(size_t)c * NT + row];
                    const float y = x0 * (v * nrm + Z[(size_t)c * NT + row] * sk);
                    ATT[(size_t)row * 1024 + 512 + c] = f2bf(y);
                }
            }
        }
#undef HY_LOADW
    }
    {
        float* zs = (float*)smraw; float* hw = zs + 512;
        for (int c = bid; c < 512; c += nb) {
            __syncthreads();
            if (tid < 256) zs[tid] = Z[(size_t)c * NT + tid];
            hw[tid] = (tid < 511) ? HFC[(size_t)c * 512 + 256 - 255 + tid] : 0.f;
            __syncthreads();
            if (tid < 256) {
                float acc = 0.f;
                const float* hp = hw + tid + 255;
                for (int j = 0; j < 256; ++j) acc += hp[-j] * zs[j];
                float nrm = 0.f;
#pragma unroll
                for (int w_ = 0; w_ < 8; ++w_) nrm += ((const float*)(P.ws + WS_NORMP))[(size_t)c * 520 + 512 + w_];
                const float x0 = short_conv(QK, cw, cb, tid, c, 0, NCTX);
                const float y = x0 * (acc / nrm + zs[tid] * skip[c]);
                ATT[(size_t)tid * 1024 + 512 + c] = f2bf(y);
            }
        }
    }
}

__device__ __forceinline__ void phase_ln_router(const Params& P, int layer, int tok0, int ntok, unsigned char* smraw, int bid, int nb, int probe = 0) {
    const bfr* PRE = (const bfr*)(P.ws + WS_PRE);
    bfr* X1 = (bfr*)(P.ws + WS_X1);
    bfr* HFF = (bfr*)(P.ws + WS_HFF);
    const float* mod = (const float*)(P.ws + WS_MOD) + (size_t)layer * 2 * 6144;
    const float* lg_ = P.in[6] + layer * 1024; const float* lb_ = P.in[7] + layer * 1024;
    const bfr* RT = (const bfr*)(P.ws + WS_ROUT) + (size_t)layer * 256 * 1024;
    const float* rbias = P.in[37] + layer * 256;
    int* COUNT = (probe ? (int*)(P.ws + 45056) : (int*)(P.ws + CTL_COUNT) + layer * NREP * CSTRIDE) + (bid & 7) * CSTRIDE;
    int* LIST = probe ? (int*)(P.ws + WS_YS) : (int*)(P.ws + WS_LIST);
    float* GATE = probe ? (float*)(P.ws + WS_YS + (size_t)64 * 1024 * 1024) : (float*)(P.ws + WS_GATE);
    bfr* hfs = (bfr*)smraw;
    float* lgt = (float*)(smraw + 32 * 1032 * 2);
    const int tid = threadIdx.x, lane = tid & 63, wave = tid >> 6;
    for (int u = bid; u < ntok / 32; u += nb) {
        const int r0 = tok0 + u * 32;
        __syncthreads();
        const int whu = r0 >= NCTX;
        float ga[16], be[16], a2[16], b2[16];
#pragma unroll
        for (int i = 0; i < 2; ++i) {
            const int c0 = i * 512 + lane * 8;
            float sc[8], sh[8];
            ld8(lg_ + c0, ga + i * 8); ld8(lb_ + c0, be + i * 8); ld8(mod + (size_t)whu * 6144 + 4096 + c0, sc); ld8(mod + (size_t)whu * 6144 + 3072 + c0, sh);
#pragma unroll
            for (int j = 0; j < 8; ++j) { a2[i * 8 + j] = ga[i * 8 + j] * (1.f + sc[j]); b2[i * 8 + j] = be[i * 8 + j] * (1.f + sc[j]) + sh[j]; }
        }
        uint4 raw[4][2];
#pragma unroll
        for (int q = 0; q < 4; ++q) {
            const bfr* src = PRE + (size_t)(r0 + wave * 4 + q) * 1024 + lane * 8;
            raw[q][0] = *(const uint4*)src; raw[q][1] = *(const uint4*)(src + 512);
        }
#pragma unroll
        for (int q = 0; q < 4; ++q) {
            const int rl = wave * 4 + q, row = r0 + rl;
            float v[16];
            up8(raw[q][0], v); up8(raw[q][1], v + 8);
            float s = 0.f;
#pragma unroll
            for (int i = 0; i < 16; ++i) s += v[i];
            const float mu = wave_sum(s) * (1.f / 1024.f);
            float s2 = 0.f;
#pragma unroll
            for (int i = 0; i < 16; ++i) { const float d = v[i] - mu; s2 += d * d; }
            const float rstd = rsqrtf(wave_sum(s2) * (1.f / 1024.f) + 1e-5f);
#pragma unroll
            for (int i = 0; i < 2; ++i) {
                const int c0 = i * 512 + lane * 8;
                float x[8], hf[8];
#pragma unroll
                for (int j = 0; j < 8; ++j) { const float n_ = (v[i * 8 + j] - mu) * rstd; x[j] = n_ * ga[i * 8 + j] + be[i * 8 + j]; hf[j] = n_ * a2[i * 8 + j] + b2[i * 8 + j]; }
                *(uint4*)(X1 + (size_t)row * 1024 + c0) = pack8(x);
                const uint4 pk = pack8(hf);
                *(uint4*)(HFF + (size_t)row * 1024 + c0) = pk;
                *(uint4*)(hfs + rl * 1032 + c0) = pk;
            }
        }
        __syncthreads();
        if (probe < 3) {
            f32x16 acc;
#pragma unroll
            for (int r = 0; r < 16; ++r) acc[r] = 0.f;
            const bfr* bp = RT + ((size_t)wave * 64 + lane) * 8;
            const bfr* ap = hfs + (lane & 31) * 1032 + (lane >> 5) * 8;
#pragma unroll 8
            for (int k = 0; k < 64; ++k) {
                const bf16x8 a = *(const bf16x8*)(ap + k * 16);
                const bf16x8 b = *(const bf16x8*)(bp + (size_t)k * 8 * 64 * 8);
                acc = __builtin_amdgcn_mfma_f32_32x32x16_bf16(a, b, acc, 0, 0, 0);
            }
#pragma unroll
            for (int r = 0; r < 16; ++r) {
                const int row = (r & 3) + 8 * (r >> 2) + 4 * (lane >> 5);
                lgt[row * 257 + wave * 32 + (lane & 31)] = acc[r];
            }
        }
        __syncthreads();
        float rb[4];
#pragma unroll
        for (int j = 0; j < 4; ++j) rb[j] = rbias[lane * 4 + j];
        int selE[4]; float selG[4];
        if (probe < 2) {
#pragma unroll
        for (int q = 0; q < 4; ++q) {
            const int rl = wave * 4 + q;
            float b[4];
#pragma unroll
            for (int j = 0; j < 4; ++j) b[j] = sigmoidf_(lgt[rl * 257 + lane * 4 + j]) + rb[j];
            float m1 = -1e30f, m2 = -1e30f;
#pragma unroll
            for (int j = 0; j < 4; ++j) { const float v = b[j]; if (v > m1) { m2 = m1; m1 = v; } else if (v > m2) m2 = v; }
#pragma unroll
#define TOP2_STEP(CTRL) do { \
                const float o1 = __int_as_float(__builtin_amdgcn_update_dpp(0, __float_as_int(m1), CTRL, 0xf, 0xf, true)); \
                const float o2 = __int_as_float(__builtin_amdgcn_update_dpp(0, __float_as_int(m2), CTRL, 0xf, 0xf, true)); \
                const float n1 = fmaxf(m1, o1), n2 = fmaxf(fminf(m1, o1), fmaxf(m2, o2)); \
                m1 = n1; m2 = n2; } while (0)
            TOP2_STEP(0xB1); TOP2_STEP(0x4E); TOP2_STEP(0x141);
#undef TOP2_STEP
            const float gs = m1 + m2;
            const int g = lane >> 3;
            int rank = 0;
#pragma unroll
            for (int g2 = 0; g2 < 8; ++g2) { const float v = __int_as_float(__builtin_amdgcn_readlane(__float_as_int(gs), g2 * 8)); rank += (v > gs) || (v == gs && g2 < g); }
            if (rank >= 4) {
#pragma unroll
                for (int j = 0; j < 4; ++j) b[j] = -1e30f;
            }
            int myE = 0; float myG = 0.f;
            for (int k = 0; k < 8; ++k) {
                float bv = b[0]; int bj = 0; float bb = rb[0];
#pragma unroll
                for (int j = 1; j < 4; ++j) if (b[j] > bv) { bv = b[j]; bj = j; bb = rb[j]; }
                const float wm = wave_max_dpp(bv);
                const unsigned long long bal = __ballot(bv == wm);
                const int src = __ffsll((long long)bal) - 1;
                const int e = __builtin_amdgcn_readlane(lane * 4 + bj, src);
                const float sc = __int_as_float(__builtin_amdgcn_readlane(__float_as_int(bv - bb), src));
                if (lane == k) { myE = e; myG = sc; }
                if (lane == src) {
#pragma unroll
                    for (int j = 0; j < 4; ++j) if (j == bj) b[j] = -1e30f;
                }
            }
            const float gsum = wave_sum(lane < 8 ? myG : 0.f);
            selE[q] = myE; selG[q] = 2.5f * myG / gsum;
        }
        int pos[4];
        if (lane < 8) {
#pragma unroll
            for (int q = 0; q < 4; ++q) pos[q] = atomicAdd(&COUNT[selE[q]], 1);
#pragma unroll
            for (int q = 0; q < 4; ++q) {
                const int tl = r0 + wave * 4 + q - tok0;
                LIST[((size_t)(bid & 7) * 256 + selE[q]) * LCAP + pos[q]] = tl * 9 + lane;
                GATE[(size_t)tl * 9 + lane] = selG[q];
            }
        } else if (lane == 8) {
#pragma unroll
            for (int q = 0; q < 4; ++q) GATE[(size_t)(r0 + wave * 4 + q - tok0) * 9 + 8] = 1.f;
        }
        }
    }
}

__device__ __forceinline__ void moe_prefix(const int* COUNT, int ntok, int* pre) {
    const int t = threadIdx.x, lane = t & 63, wave = t >> 6;
    __syncthreads();
    int v = 0;
    if (t < NE1) {
        int c = 0;
        if (t < 256) {
#pragma unroll
            for (int x = 0; x < NREP; ++x) { pre[1360 + t * NREP + x] = c; c += COUNT[x * CSTRIDE + t]; }
        } else c = ntok;
        v = (c + 191) / 192; pre[272 + t] = c;
    }
    int inc = v;
#pragma unroll
    for (int o = 1; o < 64; o <<= 1) { const int u = __shfl_up(inc, o, 64); if (lane >= o) inc += u; }
    if (lane == 63) pre[260 + wave] = inc;
    __syncthreads();
    int off = 0;
    for (int w = 0; w < wave; ++w) off += pre[260 + w];
    __syncthreads();
    if (t < NE1) pre[t] = off + inc - v;
    if (t == NE1 - 1) pre[NE1] = off + inc;
    __syncthreads();
}
__device__ __forceinline__ int moe_row_pidx(const int* pre, const int* LIST, int e, int r) {
    const int* pf = pre + 1360 + e * NREP;
    int x = 0;
#pragma unroll
    for (int i = 1; i < NREP; ++i) x += (pf[i] <= r);
    return LIST[((size_t)x * 256 + e) * LCAP + (r - pf[x])];
}
__device__ __forceinline__ void moe_local(const int* pre, int* lpre, int x) {
    if (threadIdx.x == 0) {
        int s = 0;
        for (int k = 0; k < 32; ++k) { lpre[k] = s; s += pre[x + 8 * k + 1] - pre[x + 8 * k]; }
        lpre[32] = s;
        const int nsh = pre[NE1] - pre[256];
        lpre[33] = s + (nsh > x ? (nsh - x + 7) / 8 : 0);
    }
    __syncthreads();
}
__device__ __forceinline__ void moe_unit(const int* pre, const int* lpre, int x, int lb, int& e, int& rb) {
    if (lb < lpre[32]) {
        int lo = 0, hi = 32;
        while (hi - lo > 1) { const int mid = (lo + hi) >> 1; if (lpre[mid] <= lb) lo = mid; else hi = mid; }
        e = x + 8 * lo; rb = lb - lpre[lo];
    } else { e = 256; rb = (lb - lpre[32]) * 8 + x; }
}
struct EpiM1 {
    bfr* H1; int rowbase; int colbase;
    __device__ __forceinline__ bool direct() const { return false; }
    __device__ __forceinline__ void tile(const f32x16&, int, int, int, int, int) {}
    template <int BM, int BN> __device__ __forceinline__ void rows(const float* Ct, int cstr) {
        for (int id_ = threadIdx.x; id_ < BM * 16; id_ += NTHR) {
            const int r = id_ >> 4, f0 = (id_ & 15) * 8;
            const int cg = (f0 >> 5) * 64 + (f0 & 31);
            float g[8], u[8], h[8]; ld8(Ct + r * cstr + cg, g); ld8(Ct + r * cstr + cg + 32, u);
#pragma unroll
            for (int j = 0; j < 8; ++j) h[j] = siluf_(g[j]) * u[j];
            *(uint4*)&H1[((size_t)rowbase + r) * 256 + colbase + f0] = pack8(h);
        }
    }
    template <int BN> __device__ __forceinline__ void rows3(const float* Ct, int cstr, int mi) {
        for (int id_ = threadIdx.x; id_ < 64 * 16; id_ += NTHR) {
            const int lr = id_ >> 4, f0 = (id_ & 15) * 8;
            const int r = (lr >> 5) * 96 + mi * 32 + (lr & 31);
            const int cg = (f0 >> 5) * 64 + (f0 & 31);
            float g[8], u[8], h[8]; ld8(Ct + lr * cstr + cg, g); ld8(Ct + lr * cstr + cg + 32, u);
#pragma unroll
            for (int j = 0; j < 8; ++j) h[j] = siluf_(g[j]) * u[j];
            *(uint4*)&H1[((size_t)rowbase + r) * 256 + colbase + f0] = pack8(h);
        }
    }
};
__device__ __forceinline__ void phase_moe1(const Params& P, int layer, int tok0, int ntok, unsigned char* smraw, int bid, int nb) {
    const int* COUNT = (const int*)(P.ws + CTL_COUNT) + layer * NREP * CSTRIDE;
    const int* LIST = (const int*)(P.ws + WS_LIST);
    const bfr* HFF = (const bfr*)(P.ws + WS_HFF);
    bfr* H1 = (bfr*)(P.ws + WS_H1);
    bfr* smem = (bfr*)smraw;
    int* pre = (int*)(smraw + MOE_TAB_OFF);
    int* lpre = pre + 928;
    moe_prefix(COUNT, ntok, pre);
    const int xg = bid & 7, rank = bid >> 3, nrank = nb >> 3;
    moe_local(pre, lpre, xg);
    const int nunits = lpre[33] * 2;
    const int tid = threadIdx.x;
    GemmPipe<192, 256, 1024, ALoadRows, BLoadF32<256>> gp;
    ALoadRows al; BLoadF32<256> bl; bl.ldn = 256;
    EpiM1 ep, epn; ep.H1 = H1; epn.H1 = H1;
#define M1_SETUP(U, PAR, EPX) do { \
        const int nh_ = (U) & 1; int e_, rb_; moe_unit(pre, lpre, xg, (U) >> 1, e_, rb_); \
        const int blk_ = pre[e_] + rb_, cnt_ = pre[272 + e_]; \
        int* ridx_ = pre + 544 + (PAR) * 192; \
        if (tid < 192) { int r_ = rb_ * 192 + tid; if (r_ >= cnt_) r_ = cnt_ - 1; \
            const int pidx_ = (e_ < 256) ? moe_row_pidx(pre, LIST, e_, r_) : r_ * 9 + 8; ridx_[tid] = tok0 + pidx_ / 9; } \
        __syncthreads(); \
        al.init<192>(HFF, 1024, 0, NT - 1, ridx_); \
        const float* Wg_ = (e_ < 256) ? P.in[38] + ((size_t)layer * 256 + e_) * 1024 * 256 : P.in[41] + (size_t)layer * 1024 * 256; \
        const float* Wu_ = (e_ < 256) ? P.in[39] + ((size_t)layer * 256 + e_) * 1024 * 256 : P.in[42] + (size_t)layer * 1024 * 256; \
        { const int n_ = (tid & 63) * 4, wn_ = n_ >> 6, j_ = n_ & 63; \
          bl.p[0] = ((j_ < 32) ? Wg_ : Wu_) + (size_t)(tid >> 6) * 4 * 256 + nh_ * 128 + wn_ * 32 + (j_ & 31); } \
        EPX.rowbase = blk_ * 192; EPX.colbase = nh_ * 128; } while (0)
    int u = rank, par = 0;
    if (u < nunits) { M1_SETUP(u, par, ep); gp.prefetch(al, bl); }
    while (u < nunits) {
        gp.mainloop(smem, al, bl);
        const int un = u + nrank;
        if (un < nunits) { M1_SETUP(un, par ^ 1, epn); gp.prefetch(al, bl); }
        gp.epilogue(smem, ep);
        ep.rowbase = epn.rowbase; ep.colbase = epn.colbase;
        u = un; par ^= 1;
    }
#undef M1_SETUP
}
struct EpiM2 {
    bfr* YS; const int* rp; const float* GATE; int col0;
    __device__ __forceinline__ bool direct() const { return false; }
    __device__ __forceinline__ void tile(const f32x16&, int, int, int, int, int) {}
    template <int BM, int BN> __device__ __forceinline__ void rows(const float* Ct, int cstr) {
        ROWS_LOOP(BM, BN) {
            const int r = id_ / (BN / 8), c = (id_ % (BN / 8)) * 8;
            const int pidx = rp[r];
            if (pidx >= 0) {
                const float g = GATE[r];
                float v[8]; ld8(Ct + r * cstr + c, v);
#pragma unroll
                for (int j = 0; j < 8; ++j) v[j] *= g;
                *(uint4*)&YS[(size_t)pidx * 1024 + col0 + c] = pack8(v);
            }
        }
    }
    template <int BN> __device__ __forceinline__ void rows3(const float* Ct, int cstr, int mi) {
        for (int id_ = threadIdx.x; id_ < 64 * (BN / 8); id_ += NTHR) {
            const int lr = id_ / (BN / 8), c = (id_ % (BN / 8)) * 8;
            const int r = (lr >> 5) * 96 + mi * 32 + (lr & 31);
            const int pidx = rp[r];
            if (pidx >= 0) {
                const float g = GATE[r];
                float v[8]; ld8(Ct + lr * cstr + c, v);
#pragma unroll
                for (int j = 0; j < 8; ++j) v[j] *= g;
                *(uint4*)&YS[(size_t)pidx * 1024 + col0 + c] = pack8(v);
            }
        }
    }
};
__device__ __forceinline__ void phase_moe2(const Params& P, int layer, int tok0, int ntok, unsigned char* smraw, int bid, int nb) {
    const int* COUNT = (const int*)(P.ws + CTL_COUNT) + layer * NREP * CSTRIDE;
    const int* LIST = (const int*)(P.ws + WS_LIST);
    const bfr* H1 = (const bfr*)(P.ws + WS_H1);
    const float* GATEW = (const float*)(P.ws + WS_GATE);
    bfr* smem = (bfr*)smraw;
    int* pre = (int*)(smraw + MOE_TAB_OFF);
    int* lpre = pre + 928;
    moe_prefix(COUNT, ntok, pre);
    const int xg = bid & 7, rank = bid >> 3, nrank = nb >> 3;
    moe_local(pre, lpre, xg);
    const int nunits = lpre[33] * 4;
    const int tid = threadIdx.x;
    GemmPipe<192, 256, 256, ALoadRows, BLoadF32<256>> gp;
    ALoadRows al; BLoadF32<256> bl; bl.ldn = 1024;
    EpiM2 ep{(bfr*)(P.ws + WS_YS), nullptr, nullptr, 0}, epn{(bfr*)(P.ws + WS_YS), nullptr, nullptr, 0};
#define M2_SETUP(U, PAR, EPX) do { \
        const int nq_ = (U) & 3; int e_, rb_; moe_unit(pre, lpre, xg, (U) >> 2, e_, rb_); \
        const int blk_ = pre[e_] + rb_, cnt_ = pre[272 + e_]; \
        int* rp_ = pre + 544 + (PAR) * 192; float* rg_ = (float*)(pre + 976 + (PAR) * 192); \
        if (tid < 192) { const int r_ = rb_ * 192 + tid; \
            const int pidx_ = (r_ < cnt_) ? ((e_ < 256) ? moe_row_pidx(pre, LIST, e_, r_) : r_ * 9 + 8) : -1; \
            rp_[tid] = pidx_; rg_[tid] = (pidx_ >= 0) ? GATEW[pidx_] : 0.f; } \
        __syncthreads(); \
        al.init<192>(H1, 256, blk_ * 192, (int)H1ROWS - 1, nullptr); \
        const float* Wd_ = (e_ < 256) ? P.in[40] + ((size_t)layer * 256 + e_) * 256 * 1024 : P.in[43] + (size_t)layer * 256 * 1024; \
        bl.p[0] = Wd_ + (size_t)(tid >> 6) * 4 * 1024 + nq_ * 256 + (tid & 63) * 4; \
        EPX.rp = rp_; EPX.GATE = rg_; EPX.col0 = nq_ * 256; } while (0)
    int u = rank, par = 0;
    if (u < nunits) { M2_SETUP(u, par, ep); gp.prefetch(al, bl); }
    while (u < nunits) {
        gp.mainloop(smem, al, bl);
        const int un = u + nrank;
        if (un < nunits) { M2_SETUP(un, par ^ 1, epn); gp.prefetch(al, bl); }
        gp.epilogue(smem, ep);
        ep.rp = epn.rp; ep.GATE = epn.GATE; ep.col0 = epn.col0;
        u = un; par ^= 1;
    }
#undef M2_SETUP
}

__device__ __forceinline__ void phase_combine(const Params& P, int layer, int tok0, int ntok, int bid, int nb) {
    const bfr* YS = (const bfr*)(P.ws + WS_YS);
    const bfr* X1 = (const bfr*)(P.ws + WS_X1);
    const float* mod = (const float*)(P.ws + WS_MOD) + (size_t)layer * 2 * 6144;
    const float* modn = (const float*)(P.ws + WS_MOD) + (size_t)2 * 6144;
    const float* lg_ = P.in[8] + layer * 1024; const float* lb_ = P.in[9] + layer * 1024;
    const int lane = threadIdx.x & 63, wave = threadIdx.x >> 6;
    for (int t8 = bid; t8 < ntok / 8; t8 += nb) {
        const int tl = t8 * 8 + wave, row = tok0 + tl;
        const int wh = row >= NCTX;
        uint4 raw[9][2], xr[2];
        {
            const bfr* src = YS + (size_t)tl * 9 * 1024 + lane * 8;
#pragma unroll
            for (int k = 0; k < 9; ++k) { raw[k][0] = *(const uint4*)(src + k * 1024); raw[k][1] = *(const uint4*)(src + k * 1024 + 512); }
            xr[0] = *(const uint4*)(X1 + (size_t)row * 1024 + lane * 8); xr[1] = *(const uint4*)(X1 + (size_t)row * 1024 + 512 + lane * 8);
        }
        float y[16];
#pragma unroll
        for (int i = 0; i < 16; ++i) y[i] = 0.f;
#pragma unroll
        for (int k = 0; k < 9; ++k)
#pragma unroll
            for (int i = 0; i < 2; ++i) { float f[8]; up8(raw[k][i], f);
#pragma unroll
                for (int j = 0; j < 8; ++j) y[i * 8 + j] += f[j]; }
        const float* g2 = mod + (size_t)wh * 6144 + 5120;
        float v[16]; float s = 0.f;
#pragma unroll
        for (int i = 0; i < 2; ++i) {
            const int c0 = i * 512 + lane * 8;
            float x[8], g[8]; up8(xr[i], x); ld8(g2 + c0, g);
#pragma unroll
            for (int j = 0; j < 8; ++j) { v[i * 8 + j] = ALPHA * x[j] + g[j] * y[i * 8 + j]; s += v[i * 8 + j]; }
        }
        const float mu = wave_sum(s) * (1.f / 1024.f);
        float s2 = 0.f;
#pragma unroll
        for (int i = 0; i < 16; ++i) { const float d = v[i] - mu; s2 += d * d; }
        const float rstd = rsqrtf(wave_sum(s2) * (1.f / 1024.f) + 1e-5f);
#pragma unroll
        for (int i = 0; i < 2; ++i) {
            const int c0 = i * 512 + lane * 8;
            float x[8], ga[8], be[8]; ld8(lg_ + c0, ga); ld8(lb_ + c0, be);
#pragma unroll
            for (int j = 0; j < 8; ++j) x[j] = (v[i * 8 + j] - mu) * rstd * ga[j] + be[j];
            if (layer == 0) {
                *(uint4*)((bfr*)(P.ws + WS_X2) + (size_t)row * 1024 + c0) = pack8(x);
                float sh[8], sc[8], hh[8]; ld8(modn + (size_t)wh * 6144 + c0, sh); ld8(modn + (size_t)wh * 6144 + 1024 + c0, sc);
#pragma unroll
                for (int j = 0; j < 8; ++j) hh[j] = x[j] * (1.f + sc[j]) + sh[j];
                *(uint4*)((bfr*)(P.ws + WS_H) + (size_t)row * 1024 + c0) = pack8(hh);
            } else {
                float* o = P.out + (size_t)(row - NCTX) * 1024 + c0;
                *(float4*)o = make_float4(x[0], x[1], x[2], x[3]); *(float4*)(o + 4) = make_float4(x[4], x[5], x[6], x[7]);
            }
        }
    }
}

__device__ __forceinline__ int s5_row(int dir, int n) { return dir == 0 ? n : (n < NCTX ? NCTX - 1 - n : NT + NCTX - 1 - n); }

__device__ __forceinline__ void phase_qkprep_s5a(const Params& P, float* sm, int bid, int nb) {
    const bfr* QK = (const bfr*)(P.ws + WS_QKVU);
    unsigned char* QN = (unsigned char*)(P.ws + WS_QN); unsigned char* KN = (unsigned char*)(P.ws + WS_KN);
    const int lane = threadIdx.x & 63, wave = threadIdx.x >> 6;
    const int gw = bid * 8 + wave, nw = nb * 8;
    const float qg = P.in[24][lane], kg = P.in[25][lane];
    const int fi = (lane & 31) >> 1;
    const float invf = exp2f(-(float)fi * (13.287712379549449f / 16.f));
    for (int row = gw; row < NT; row += nw) {
        const bool lat = row >= NCTX;
        float cs = 1.f, sn = 0.f;
        if (lat) {
            const int t = row - NCTX;
            const float ang = (float)((lane < 32) ? (t >> 6) : (t & 63)) * invf;
            cs = __cosf(ang); sn = __sinf(ang);
        }
        const bfr* src = QK + (size_t)row * 1280 + lane;
#pragma unroll
        for (int slot = lat ? 0 : 8; slot < 10; ++slot) {
            const float x = bf2f(src[slot * 64]);
            const float ss = wave_sum(x * x);
            float y = x * rsqrtf(ss * (1.f / 64.f) + 1e-6f) * (slot < 8 ? qg : kg);
            if (lat) {
                const float other = __shfl_xor(y, 1, 64);
                y = (lane & 1) ? (other * sn + y * cs) : (y * cs - other * sn);
            }
            if (slot < 8) QN[(size_t)(row - NCTX) * 512 + slot * 64 + lane] = f2fp8(y * (0.5f * 1.4426950408889634f));
            else KN[(size_t)row * 128 + (slot - 8) * 64 + lane] = f2fp8(y * 0.25f);
        }
    }
    {
        unsigned char* VT = (unsigned char*)(P.ws + WS_VT);
        unsigned char* tile = (unsigned char*)sm;
        for (int u = bid; u < NT / 64; u += nb) {
            __syncthreads();
            for (int e = threadIdx.x; e < 64 * 128; e += NTHR) {
                const int r = e >> 7, c = e & 127;
                const int pos = ((r >> 2) & 1) * 32 + (r >> 5) * 16 + ((r >> 3) & 3) * 4 + (r & 3);
                tile[c * 68 + pos] = f2fp8(bf2f(QK[(size_t)(u * 64 + r) * 1280 + 640 + c]));
            }
            __syncthreads();
            for (int e = threadIdx.x; e < 128 * 16; e += NTHR) { const int c = e >> 4, w = e & 15; *(unsigned*)&VT[(size_t)c * NT + u * 64 + w * 4] = *(const unsigned*)&tile[c * 68 + w * 4]; }
        }
        __syncthreads();
    }
    {
        const bfr* S5E = (const bfr*)(P.ws + WS_S5E);
        float2* SE = (float2*)(P.ws + WS_SE);
        for (int item = wave * nb + bid; item < 64 * 9 * 2; item += nw) {
            const int dg = item & 63, ph = (item >> 6) & 1, nt9 = item >> 7;
            const int dir = dg >> 5, g = dg & 31;
            const int c = nt9 * 32 + (lane & 31), cc = c < 260 ? c : 259;
            f32x16 a0, a1;
#pragma unroll
            for (int q = 0; q < 16; ++q) { a0[q] = 0.f; a1[q] = 0.f; }
            const bfr* e0 = S5E + ((size_t)dg * 4 + ph) * 64 * 512 + lane * 8;
            const bfr* e1 = e0 + (size_t)2 * 64 * 512;
            const bfr* ub = QK + 768 + g * 16 + (lane >> 5) * 8;
#pragma unroll 8
            for (int i = 0; i < 64; ++i) {
                const int row = s5_row(dir, cc * 64 + i);
                const bf16x8 bfrag = *(const bf16x8*)(ub + (size_t)row * 1280);
                const bf16x8 f0 = *(const bf16x8*)(e0 + (size_t)i * 512), f1 = *(const bf16x8*)(e1 + (size_t)i * 512);
                a0 = __builtin_amdgcn_mfma_f32_32x32x16_bf16(f0, bfrag, a0, 0, 0, 0);
                a1 = __builtin_amdgcn_mfma_f32_32x32x16_bf16(f1, bfrag, a1, 0, 0, 0);
            }
            if (c < 260) {
#pragma unroll
                for (int q = 0; q < 16; ++q) {
                    const int pp = ph * 32 + (q & 3) + 8 * (q >> 2) + 4 * (lane >> 5);
                    SE[((size_t)c * 64 + dg) * 64 + pp] = make_float2(a0[q], a1[q]);
                }
            }
        }
    }
}

#define GK_STR 72
#define GV_STR 68
__device__ __forceinline__ void phase_s5b_gqa(const Params& P, unsigned char* smraw, int bid, int nb) {
    if (bid < 8) {
        const int i = bid * NTHR + threadIdx.x;
        const float2 a = ((const float2*)(P.ws + WS_A64))[i];
        const float2* SE = (const float2*)(P.ws + WS_SE);
        float2* CIN = (float2*)(P.ws + WS_CIN);
        float sr = 0.f, si = 0.f;
        for (int c0 = 0; c0 < 260; c0 += 20) {
            float2 e[20];
#pragma unroll
            for (int j = 0; j < 20; ++j) e[j] = SE[(size_t)(c0 + j) * 4096 + i];
#pragma unroll
            for (int j = 0; j < 20; ++j) {
                CIN[(size_t)(c0 + j) * 4096 + i] = make_float2(sr, si);
                const float nr = a.x * sr - a.y * si + e[j].x, ni = a.x * si + a.y * sr + e[j].y;
                sr = nr; si = ni;
            }
        }
    }
    const unsigned char* QN = (const unsigned char*)(P.ws + WS_QN); const unsigned char* KN = (const unsigned char*)(P.ws + WS_KN);
    const unsigned char* VT = (const unsigned char*)(P.ws + WS_VT);
    bfr* ATT = (bfr*)(P.ws + WS_ATT);
    constexpr int GK8 = 80;
    unsigned char* Ks = smraw;
    unsigned char* Vs = Ks + 2 * 64 * GK8;
    const int tid = threadIdx.x, lane = tid & 63, wave = tid >> 6, r = lane & 31, h = lane >> 5;
    float gqm = fabsf(P.in[24][lane]), gkm = fabsf(P.in[25][lane]);
#pragma unroll
    for (int o = 32; o > 0; o >>= 1) { gqm = fmaxf(gqm, __shfl_xor(gqm, o, 64)); gkm = fmaxf(gkm, __shfl_xor(gkm, o, 64)); }
    const float negm0 = -(8.f * gqm * gkm * 1.4426950408889634f * 1.02f + 0.5f) + 10.f;
    constexpr int NTL = NT / 64;
    const int one8 = 0x7f7f7f7f;
    for (int u = bid; u < 256; u += nb) {
        const int qb = u >> 1, kvh = u & 1;
        const int head = kvh * 4 + (wave >> 1);
        const int tq0 = qb * 128 + (wave & 1) * 64 + r;
        unsigned char* Qw = Vs + 2 * 64 * GK8 + wave * 64 * GK8;
        __syncthreads();
#pragma unroll
        for (int i = 0; i < 4; ++i) {
            const int row = i * 16 + (lane >> 2), ch = lane & 3;
            *(u32x4*)&Qw[row * GK8 + ch * 16] = *(const u32x4*)(QN + (size_t)(qb * 128 + (wave & 1) * 64 + row) * 512 + head * 64 + ch * 16);
        }
        f32x16 o[2][2];
#pragma unroll
        for (int qt = 0; qt < 2; ++qt)
#pragma unroll
            for (int i = 0; i < 2; ++i)
#pragma unroll
                for (int q = 0; q < 16; ++q) o[qt][i][q] = 0.f;
        hf32x2_t l2[2][2] = {{{0.f, 0.f}, {0.f, 0.f}}, {{0.f, 0.f}, {0.f, 0.f}}};
        const int sr = tid >> 3, sc = tid & 7;
        const unsigned char* kp = KN + (size_t)sr * 128 + kvh * 64 + sc * 8;
        const unsigned char* vp = VT + (size_t)(kvh * 64 + sr) * NT + sc * 8;
        unsigned char* kdst = Ks + sr * GK8 + sc * 8;
        unsigned char* vdst = Vs + sr * GK8 + sc * 8;
        u32x2 rk = *(const u32x2*)kp, rv = *(const u32x2*)vp;
        __syncthreads();
        *(u32x2*)kdst = rk;
        *(u32x2*)vdst = rv;
        __syncthreads();
        v8i_t qf[2];
#pragma unroll
        for (int qt = 0; qt < 2; ++qt) {
            const u32x4 a = *(const u32x4*)&Qw[(qt * 32 + r) * GK8 + h * 32], b2 = *(const u32x4*)&Qw[(qt * 32 + r) * GK8 + h * 32 + 16];
            qf[qt] = (v8i_t){(int)a.x, (int)a.y, (int)a.z, (int)a.w, (int)b2.x, (int)b2.y, (int)b2.z, (int)b2.w};
        }
#pragma unroll 1
        for (int tile = 0; tile < NTL; ++tile) {
            const int cb = tile & 1;
            const bool more = tile + 1 < NTL;
            if (more) { rk = *(const u32x2*)(kp + (size_t)(tile + 1) * 64 * 128); rv = *(const u32x2*)(vp + (tile + 1) * 64); }
            const unsigned char* Kb = Ks + cb * 64 * GK8;
            const unsigned char* Vb = Vs + cb * 64 * GK8;
            f32x16 s[2][2];
#pragma unroll
            for (int qt = 0; qt < 2; ++qt)
#pragma unroll
                for (int kt = 0; kt < 2; ++kt)
#pragma unroll
                    for (int q = 0; q < 16; ++q) s[qt][kt][q] = negm0;
            __builtin_amdgcn_s_setprio(1);
#pragma unroll
            for (int kt = 0; kt < 2; ++kt) {
                const u32x4 a = *(const u32x4*)&Kb[(kt * 32 + r) * GK8 + h * 32], b2 = *(const u32x4*)&Kb[(kt * 32 + r) * GK8 + h * 32 + 16];
                const v8i_t kf = (v8i_t){(int)a.x, (int)a.y, (int)a.z, (int)a.w, (int)b2.x, (int)b2.y, (int)b2.z, (int)b2.w};
                s[0][kt] = __builtin_amdgcn_mfma_scale_f32_32x32x64_f8f6f4(kf, qf[0], s[0][kt], 0, 0, 0, one8, 0, one8);
                s[1][kt] = __builtin_amdgcn_mfma_scale_f32_32x32x64_f8f6f4(kf, qf[1], s[1][kt], 0, 0, 0, one8, 0, one8);
            }
            v8i_t pf[2];
#pragma unroll
            for (int qt = 0; qt < 2; ++qt)
#pragma unroll
                for (int kt = 0; kt < 2; ++kt)
#pragma unroll
                    for (int g = 0; g < 4; ++g) {
                        const float p0 = __builtin_amdgcn_exp2f(s[qt][kt][4 * g + 0]), p1 = __builtin_amdgcn_exp2f(s[qt][kt][4 * g + 1]);
                        const float p2 = __builtin_amdgcn_exp2f(s[qt][kt][4 * g + 2]), p3 = __builtin_amdgcn_exp2f(s[qt][kt][4 * g + 3]);
                        l2[qt][0] += (hf32x2_t){p0, p1}; l2[qt][1] += (hf32x2_t){p2, p3};
                        int pk; asm volatile("" : "=v"(pk));
                        pk = __builtin_amdgcn_cvt_pk_bf8_f32(p0, p1, pk, false);
                        pk = __builtin_amdgcn_cvt_pk_bf8_f32(p2, p3, pk, true);
                        pf[qt][kt * 4 + g] = pk;
                    }
#pragma unroll
            for (int dt = 0; dt < 2; ++dt) {
                const u32x4 a = *(const u32x4*)&Vb[(dt * 32 + r) * GK8 + h * 32], b2 = *(const u32x4*)&Vb[(dt * 32 + r) * GK8 + h * 32 + 16];
                const v8i_t vf = (v8i_t){(int)a.x, (int)a.y, (int)a.z, (int)a.w, (int)b2.x, (int)b2.y, (int)b2.z, (int)b2.w};
                o[0][dt] = __builtin_amdgcn_mfma_scale_f32_32x32x64_f8f6f4(vf, pf[0], o[0][dt], 0, 1, 0, one8, 0, one8);
                o[1][dt] = __builtin_amdgcn_mfma_scale_f32_32x32x64_f8f6f4(vf, pf[1], o[1][dt], 0, 1, 0, one8, 0, one8);
            }
            __builtin_amdgcn_s_setprio(0);
            if (more) {
                *(u32x2*)(kdst + (cb ^ 1) * 64 * GK8) = rk;
                *(u32x2*)(vdst + (cb ^ 1) * 64 * GK8) = rv;
            }
            __syncthreads();
        }
#pragma unroll
        for (int qt = 0; qt < 2; ++qt) {
            const float lq = (l2[qt][0].x + l2[qt][0].y) + (l2[qt][1].x + l2[qt][1].y);
            const float lt = lq + __shfl_xor(lq, 32, 64);
            const float inv = 1.f / lt;
            bfr* op = ATT + (size_t)(NCTX + tq0 + qt * 32) * 1024 + head * 64;
#pragma unroll
            for (int dt = 0; dt < 2; ++dt)
#pragma unroll
                for (int g4 = 0; g4 < 4; ++g4) {
                    uint2 pk;
                    pk.x = pack2(o[qt][dt][g4 * 4 + 0] * inv, o[qt][dt][g4 * 4 + 1] * inv);
                    pk.y = pack2(o[qt][dt][g4 * 4 + 2] * inv, o[qt][dt][g4 * 4 + 3] * inv);
                    *(uint2*)(op + dt * 32 + g4 * 8 + h * 4) = pk;
                }
        }
    }
}

#define SSTR 136
__device__ __forceinline__ void phase_s5c(const Params& P, unsigned char* smraw, int bid, int nb) {
    const bfr* QK = (const bfr*)(P.ws + WS_QKVU);
    const float* CINF = (const float*)(P.ws + WS_CIN);
    const bfr* S5F = (const bfr*)(P.ws + WS_S5F);
    const bfr* S5G = (const bfr*)(P.ws + WS_S5G);
    const float* dsk = P.in[33];
    bfr* Y5 = (bfr*)(P.ws + WS_Y5);
    const int tid = threadIdx.x, lane = tid & 63, wave = tid >> 6;
    bfr* Us = (bfr*)smraw;
    bfr* Fs = (bfr*)(smraw + 65536);
    for (int item = bid; item < 256; item += nb) {
        const int g = item & 31, nt8 = item >> 5;
        __syncthreads();
        for (int e = tid; e < 4096; e += NTHR) {
            const int tl = e >> 6, l = e & 63;
            const int row = NCTX + (nt8 * 32 + (l & 31)) * 64 + tl;
            *(u32x4*)&Us[(size_t)e * 8] = *(const u32x4*)(QK + (size_t)row * 1280 + 768 + g * 16 + (l >> 5) * 8);
        }
        f32x16 acc[4];
#pragma unroll
        for (int m = 0; m < 4; ++m)
#pragma unroll
            for (int q = 0; q < 16; ++q) acc[m][q] = 0.f;
#pragma unroll
        for (int dir = 0; dir < 2; ++dir) {
            const int dg = dir * 32 + g;
            __syncthreads();
            for (int e = tid; e < 4096; e += NTHR) *(u32x4*)&Fs[(size_t)e * 8] = *(const u32x4*)(S5F + (size_t)dg * 32768 + (size_t)e * 8);
            __syncthreads();
#pragma unroll 2
            for (int i = 0; i < 64; ++i) {
                const bf16x8 b = *(const bf16x8*)&Us[(i * 64 + lane) * 8];
#pragma unroll
                for (int m = 0; m < 4; ++m) {
                    const int mt = wave + 8 * m;
                    const int d = dir == 0 ? 2 * mt - i + 1 : i - 2 * mt;
                    if (d >= 0 && d < 64) {
                        const bf16x8 a = *(const bf16x8*)&Fs[(d * 64 + lane) * 8];
                        acc[m] = __builtin_amdgcn_mfma_f32_32x32x16_bf16(a, b, acc[m], 0, 0, 0);
                    }
                }
            }
            const int cq = nt8 * 32 + (lane & 31);
            const int c = dir == 0 ? 4 + cq : 259 - cq;
            const float* cp = CINF + (((size_t)c * 64 + dg) * 64 + 4 * (lane >> 5)) * 2;
#pragma unroll 2
            for (int ks = 0; ks < 8; ++ks) {
                float xv[8]; ld8(cp + ks * 16, xv);
                const uint4 pk = pack8(xv);
                union { uint4 u; bf16x8 v; } cvb; cvb.u = pk;
#pragma unroll
                for (int m = 0; m < 4; ++m) {
                    const int mt = wave + 8 * m;
                    const bf16x8 a = *(const bf16x8*)(S5G + (((size_t)dg * 32 + mt) * 8 + ks) * 512 + lane * 8);
                    acc[m] = __builtin_amdgcn_mfma_f32_32x32x16_bf16(a, cvb.v, acc[m], 0, 0, 0);
                }
            }
        }
        __syncthreads();
        {
            bfr* stage = Fs;
            const int n = lane & 31, h = lane >> 5;
            float dk[8];
#pragma unroll
            for (int q8 = 0; q8 < 8; ++q8) dk[q8] = dsk[g * 16 + (q8 & 3) + 8 * (q8 >> 2) + 4 * h];
#pragma unroll
            for (int m = 0; m < 4; ++m) {
                const int mt = wave + 8 * m;
#pragma unroll
                for (int q = 0; q < 16; ++q) {
                    const int k = (q & 3) + 8 * ((q >> 2) & 1) + 4 * h, tl = 2 * mt + (q >> 3);
                    const float u = bf2f(Us[(tl * 64 + n + 32 * (k >> 3)) * 8 + (k & 7)]);
                    stage[n * 1026 + tl * 16 + k] = f2bf(gelu_tanh(acc[m][q] + dk[q & 7] * u));
                }
            }
        }
        __syncthreads();
        for (int e = tid; e < 4096; e += NTHR) {
            const int cql = e >> 7, tl = (e >> 1) & 63, kh = e & 1;
            const unsigned* sp = (const unsigned*)(Fs + cql * 1026 + tl * 16 + kh * 8);
            uint4 v; v.x = sp[0]; v.y = sp[1]; v.z = sp[2]; v.w = sp[3];
            const int t = (nt8 * 32 + cql) * 64 + tl;
            *(uint4*)&Y5[(size_t)t * 512 + g * 16 + kh * 8] = v;
        }
    }
}

struct EpiGlu {
    const bfr* Y5; const float* gb; bfr* ATT; int row0, col0;
    __device__ __forceinline__ bool direct() const { return false; }
    __device__ __forceinline__ void tile(const f32x16&, int, int, int, int, int) {}
    template <int BM, int BN> __device__ __forceinline__ void rows(const float* Ct, int cstr) {
        ROWS_LOOP(BM, BN) {
            const int r = id_ / (BN / 8), c = (id_ % (BN / 8)) * 8;
            const int t = row0 + r, col = col0 + c;
            float v[8], b[8]; ld8(Ct + r * cstr + c, v); ld8(gb + col, b);
            const uint4 yy = *(const uint4*)&Y5[(size_t)t * 512 + col];
            const float y[8] = {bflo(yy.x), bfhi(yy.x), bflo(yy.y), bfhi(yy.y), bflo(yy.z), bfhi(yy.z), bflo(yy.w), bfhi(yy.w)};
#pragma unroll
            for (int j = 0; j < 8; ++j) v[j] = y[j] * sigmoidf_(v[j] + b[j]);
            *(uint4*)&ATT[(size_t)(NCTX + t) * 1024 + 512 + col] = pack8(v);
        }
    }
};
__device__ __forceinline__ void phase_glu(const Params& P, bfr* smem, int bid, int nb) {
    const bfr* Y5 = (const bfr*)(P.ws + WS_Y5);
    const bfr* Bt = (const bfr*)(P.ws + WS_GLUT);
    constexpr int nu = 64 * 4;
    GemmPipe<256, 128, 512, ALoadRows, BLoadT> gp;
    ALoadRows al; BLoadT bl;
    int u = bid;
    if (u < nu) { al.init<256>(Y5, 512, (u >> 2) * 256, LSEQ - 1, nullptr); bl.init<128>(Bt, 512, (u & 3) * 128); gp.prefetch(al, bl); }
    while (u < nu) {
        EpiGlu ep{Y5, P.in[35], (bfr*)(P.ws + WS_ATT), (u >> 2) * 256, (u & 3) * 128};
        gp.mainloop(smem, al, bl);
        const int un = u + nb;
        if (un < nu) { al.init<256>(Y5, 512, (un >> 2) * 256, LSEQ - 1, nullptr); bl.init<128>(Bt, 512, (un & 3) * 128); gp.prefetch(al, bl); }
        gp.epilogue(smem, ep);
        u = un;
    }
}

__global__ void __launch_bounds__(NTHR, 2) fwd_kernel(Params P) {
    extern __shared__ __attribute__((aligned(16))) unsigned char lds[];
    const int bid = blockIdx.x, nb = gridDim.x;
    unsigned char* sm = lds + 16;
#if MK_SINGLE
    if (threadIdx.x == 0) { ((volatile unsigned*)lds)[0] = 0u; ((volatile unsigned*)lds)[1] = 0u; ((volatile unsigned*)lds)[2] = 0u; ((volatile unsigned*)lds)[3] = 0u; }
    __syncthreads();
    XcdBarrier bar = xcd_barrier_post((unsigned*)P.ws, (volatile LAS unsigned*)lds);
#define SEAM(k) do { if (P.lo <= (k) && (k) + 1 < P.hi) xcd_barrier(bar); } while (0)
#else
#define SEAM(k) do { } while (0)
#endif
#define IN(k) (P.lo <= (k) && (k) < P.hi)
    bfr* gsm = (bfr*)sm;
    if (IN(0)) { phase_prologue(P, (float*)sm, bid, nb); SEAM(0); }
    if (IN(1)) { if (PROBE_DUP == 102) { for (int rr_ = 0; rr_ < 4; ++rr_) phase_h0(P, bid, nb); } phase_h0(P, bid, nb); if (PROBE_DUP == 1) { phase_h0(P, bid, nb); } SEAM(1); }
    if (IN(2)) { phase_inproj0(P, gsm, bid, nb); if (PROBE_DUP == 2) { phase_inproj0(P, gsm, bid, nb); } SEAM(2); }
    if (IN(3)) { phase_na_attention(P, (float*)sm, bid, nb); phase_zprep(P, (float*)sm, bid, nb); if (PROBE_DUP == 3) { phase_na_attention(P, (float*)sm, bid, nb); } if (PROBE_DUP == 30) { phase_zprep(P, (float*)sm, bid, nb); } if (PROBE_DUP == 99) { for (int i_ = 0; i_ < 10; ++i_) xcd_barrier(bar); } SEAM(3); }
    if (IN(4)) { phase_longconv(P, sm, bid, nb); if (PROBE_DUP == 4) { phase_longconv(P, sm, bid, nb); } SEAM(4); }
    if (IN(5)) { phase_outproj(P, 0, gsm, bid, nb); if (PROBE_DUP == 5) { phase_outproj(P, 0, gsm, bid, nb); } SEAM(5); }
    if (IN(6)) { if (PROBE_DUP >= 60 && PROBE_DUP < 64) { phase_ln_router(P, 0, 0, NT, sm, bid, nb, PROBE_DUP - 59); } phase_ln_router(P, 0, 0, NT, sm, bid, nb); SEAM(6); }
    if (IN(7)) { phase_moe1(P, 0, 0, NT, sm, bid, nb); if (PROBE_DUP == 7) { phase_moe1(P, 0, 0, NT, sm, bid, nb); } SEAM(7); }
    if (IN(8)) { phase_moe2(P, 0, 0, NT, sm, bid, nb); if (PROBE_DUP == 8) { phase_moe2(P, 0, 0, NT, sm, bid, nb); } SEAM(8); }
    if (IN(9)) { phase_combine(P, 0, 0, NT, bid, nb); if (PROBE_DUP == 9) { phase_combine(P, 0, 0, NT, bid, nb); } SEAM(9); }
    if (IN(10)) { phase_gemm_bf16out((const bfr*)(P.ws + WS_H), 1024, 0, NT, (const bfr*)(P.ws + WS_WINT1), 1280, 1024, (bfr*)(P.ws + WS_QKVU), 1280, gsm, bid, nb); if (PROBE_DUP == 10) { phase_gemm_bf16out((const bfr*)(P.ws + WS_H), 1024, 0, NT, (const bfr*)(P.ws + WS_WINT1), 1280, 1024, (bfr*)(P.ws + WS_QKVU), 1280, gsm, bid, nb); } SEAM(10); }
    if (IN(11)) { phase_qkprep_s5a(P, (float*)sm, bid, nb); if (PROBE_DUP == 11) { phase_qkprep_s5a(P, (float*)sm, bid, nb); } SEAM(11); }
    if (IN(12)) { phase_s5b_gqa(P, sm, bid, nb); if (PROBE_DUP == 12) { phase_s5b_gqa(P, sm, bid, nb); } SEAM(12); }
    if (IN(13)) { phase_s5c(P, sm, bid, nb); if (PROBE_DUP == 13) { phase_s5c(P, sm, bid, nb); } SEAM(13); }
    if (IN(14)) { phase_glu(P, gsm, bid, nb); if (PROBE_DUP == 14) { phase_glu(P, gsm, bid, nb); } SEAM(14); }
    if (IN(15)) { phase_outproj(P, 1, gsm, bid, nb); SEAM(15); }
    if (IN(16)) { phase_ln_router(P, 1, NCTX, LSEQ, sm, bid, nb); SEAM(16); }
    if (IN(17)) { phase_moe1(P, 1, NCTX, LSEQ, sm, bid, nb); SEAM(17); }
    if (IN(18)) { phase_moe2(P, 1, NCTX, LSEQ, sm, bid, nb); SEAM(18); }
    if (IN(19)) { phase_combine(P, 1, NCTX, LSEQ, bid, nb); }
}

extern "C" void kernel_launch(void* const* d_in, const int* in_sizes, int n_in, void* d_out, int out_size, void* d_ws, size_t ws_size, hipStream_t stream) {
    static int grid = 0;
    if (grid == 0) {
        if (n_in != 44 || ws_size < WS_END) { fprintf(stderr, "kernel_launch: need 44 inputs and %zu bytes of workspace (got %d, %zu)\n", (size_t)WS_END, n_in, ws_size); grid = -1; return; }
        int dev = 0, cus = 0, per_cu = 0;
        hipGetDevice(&dev);
        hipDeviceGetAttribute(&cus, hipDeviceAttributeMultiprocessorCount, dev);
        if (hipFuncSetAttribute((const void*)fwd_kernel, hipFuncAttributeMaxDynamicSharedMemorySize, LDS_BYTES) != hipSuccess) { fprintf(stderr, "kernel_launch: hipFuncSetAttribute failed\n"); grid = -1; return; }
        if (hipOccupancyMaxActiveBlocksPerMultiprocessor(&per_cu, (const void*)fwd_kernel, NTHR, LDS_BYTES) != hipSuccess || per_cu < 1) { fprintf(stderr, "kernel_launch: occupancy query says %d\n", per_cu); (void)hipGetLastError(); }
        grid = (cus / 8) * 8;
    }
    if (grid < 0) return;
    hipMemsetAsync(d_ws, 0, CTL_BYTES, stream);
    Params p{};
    for (int i = 0; i < 44; ++i) p.in[i] = (const float*)d_in[i];
    p.out = (float*)d_out; p.ws = (unsigned char*)d_ws;
#if MK_SINGLE
    p.lo = 0; p.hi = NPH;
    hipLaunchKernelGGL(fwd_kernel, dim3(grid), dim3(NTHR), LDS_BYTES, stream, p);
#else
    for (int ph = 0; ph < NPH; ++ph) {
        p.lo = ph; p.hi = ph + 1;
        hipLaunchKernelGGL(fwd_kernel, dim3(grid), dim3(NTHR), LDS_BYTES, stream, p);
    }
#endif
}
```
